# Optimizing an MI355X kernel written in HIP

```python
import math
import jax, jax.numpy as jnp
from jax import lax
import numpy as np

D_MODEL = 4096
BATCH = 2
SEQ = 4096
DEPTH = 2

MIX_WIDTH = D_MODEL
SSM_WIDTH = D_MODEL // 2
RET_WIDTH = MIX_WIDTH - SSM_WIDTH
SSM_GROUP = 16
SSM_GROUPS = SSM_WIDTH // SSM_GROUP
SSM_STATE = 64
RET_HEAD_DIM = 256
RET_HEADS = RET_WIDTH // RET_HEAD_DIM
RET_CHUNK = 128
D_FF = 4 * D_MODEL
IN_WIDTH = SSM_WIDTH + 4 * RET_WIDTH
ROPE_BASE = 10000.0
EPS = 1e-6
DT_MIN = 1e-3
DT_MAX = 1e-1

kernel_name = "hymba_s5_retnet_adaln_trunk"


def rmsnorm(x, g):
    xf = x.astype(jnp.float32)
    y = xf * lax.rsqrt(jnp.mean(jnp.square(xf), axis=-1, keepdims=True) + EPS)
    return (y * g.astype(jnp.float32)).astype(x.dtype)


def rotate(t, positions):
    dh = t.shape[-1]
    inv_freq = ROPE_BASE ** (-jnp.arange(0, dh, 2, dtype=jnp.float32) / dh)
    ang = positions.astype(jnp.float32)[..., None] * inv_freq
    cos = jnp.cos(ang)[:, :, None, :]
    sin = jnp.sin(ang)[:, :, None, :]
    t1, t2 = jnp.split(t, 2, axis=-1)
    return jnp.concatenate([t1 * cos - t2 * sin, t1 * sin + t2 * cos], axis=-1)


def s5_branch(u, lam_re, lam_im, log_dt, b_re, b_im, c_re, c_im, d_skip, w_glu, b_glu, g_out):
    f32 = jnp.float32
    bsz, seq, _ = u.shape
    uf = u.astype(f32).reshape(bsz, seq, SSM_GROUPS, SSM_GROUP)
    lam = lax.complex(lam_re.astype(f32), lam_im.astype(f32))
    dt = jnp.exp(log_dt.astype(f32))[:, None]
    lam_bar = jnp.exp(lam * dt)
    b_mat = lax.complex(b_re.astype(f32), b_im.astype(f32))
    b_bar = ((lam_bar - 1.0) / lam)[..., None] * b_mat
    c_mat = lax.complex(c_re.astype(f32), c_im.astype(f32))
    bu = jnp.einsum('bsgh,gph->bsgp', uf, b_bar)
    a = jnp.broadcast_to(lam_bar, bu.shape)

    def combine(left, right):
        a_l, b_l = left
        a_r, b_r = right
        return a_r * a_l, a_r * b_l + b_r

    _, states = lax.associative_scan(combine, (a, bu), axis=1)
    y = jnp.einsum('bsgp,ghp->bsgh', states, c_mat).real \
        + d_skip.astype(f32).reshape(SSM_GROUPS, SSM_GROUP) * uf
    y = jax.nn.gelu(y.reshape(bsz, seq, SSM_WIDTH))
    y = y * jax.nn.sigmoid(y @ w_glu.astype(f32) + b_glu.astype(f32))
    return rmsnorm(y, g_out)


def retention_branch(q, k, v, g, positions, g_norm):
    f32 = jnp.float32
    bsz, seq, _ = q.shape
    H, dh = RET_HEADS, RET_HEAD_DIM
    q = rotate(q.astype(f32).reshape(bsz, seq, H, dh), positions)
    k = rotate(k.astype(f32).reshape(bsz, seq, H, dh), positions) * (dh ** -0.5)
    v = v.astype(f32).reshape(bsz, seq, H, dh)

    log_gamma = jnp.log1p(-jnp.exp2(-5.0 - jnp.arange(H, dtype=f32)))
    idx = jnp.arange(RET_CHUNK, dtype=f32)
    rel = idx[:, None] - idx[None, :]
    decay_mask = jnp.where(rel >= 0,
                           jnp.exp(log_gamma[:, None, None] * jnp.maximum(rel, 0.0)),
                           0.0)
    cross_decay = jnp.exp(log_gamma[:, None] * (idx + 1.0))
    state_decay = jnp.exp(log_gamma[:, None] * (RET_CHUNK - 1.0 - idx))
    chunk_decay = jnp.exp(log_gamma * RET_CHUNK)
    n_chunks = seq // RET_CHUNK

    def to_chunks(t):
        return t.reshape(bsz, n_chunks, RET_CHUNK, H, dh).transpose(1, 0, 3, 2, 4)

    def step(state, qkv):
        qc, kc, vc = qkv
        scores = jnp.einsum('bhnd,bhmd->bhnm', qc, kc) * decay_mask
        inner = jnp.einsum('bhnm,bhme->bhne', scores, vc)
        cross = jnp.einsum('bhnd,bhde->bhne', qc, state) * cross_decay[None, :, :, None]
        new_state = state * chunk_decay[None, :, None, None] + jnp.einsum(
            'bhmd,bhme->bhde', kc * state_decay[None, :, :, None], vc)
        return new_state, inner + cross

    state0 = jnp.zeros((bsz, H, dh, dh), f32)
    _, out = lax.scan(step, state0, (to_chunks(q), to_chunks(k), to_chunks(v)))
    out = out.transpose(1, 0, 3, 2, 4).reshape(bsz, seq, H, dh)
    mu = jnp.mean(out, axis=-1, keepdims=True)
    var = jnp.mean(jnp.square(out - mu), axis=-1, keepdims=True)
    out = ((out - mu) * lax.rsqrt(var + EPS)).reshape(bsz, seq, RET_WIDTH)
    out = out * g_norm.astype(f32)
    return out * jax.nn.silu(g.astype(f32))


def setup_inputs(seed: int = 0) -> dict:
    key = jax.random.key(seed)
    ks = jax.random.split(key, 24)
    f32 = jnp.float32
    L, D, G, P, Hc = DEPTH, D_MODEL, SSM_GROUPS, SSM_STATE, SSM_GROUP

    def nrm(k, shape, scale):
        return jax.random.normal(k, shape, f32) * scale

    x = nrm(ks[0], (BATCH, SEQ, D), 1.0)
    c = nrm(ks[1], (BATCH, D), 1.0)
    offsets = jax.random.randint(ks[2], (BATCH, 1), 0, 1024, dtype=jnp.int32)
    positions = offsets + jnp.arange(SEQ, dtype=jnp.int32)[None, :]

    w_ada = nrm(ks[3], (L, D, 6 * D), 0.5 * D ** -0.5)
    b_ada = nrm(ks[4], (L, 6 * D), 0.02)
    g_mix = 1.0 + nrm(ks[5], (L, D), 0.02)
    w_in = nrm(ks[6], (L, D, IN_WIDTH), D ** -0.5)
    n_idx = jnp.arange(P, dtype=f32)
    lam_re = -0.5 + nrm(ks[7], (L, G, P), 0.01)
    lam_im = math.pi * n_idx + nrm(ks[8], (L, G, P), 0.01)
    log_dt = jax.random.uniform(ks[9], (L, G), f32, math.log(DT_MIN), math.log(DT_MAX))
    b_re = nrm(ks[10], (L, G, P, Hc), (2.0 * Hc) ** -0.5)
    b_im = nrm(ks[11], (L, G, P, Hc), (2.0 * Hc) ** -0.5)
    c_re = nrm(ks[12], (L, G, Hc, P), (2.0 * P) ** -0.5)
    c_im = nrm(ks[13], (L, G, Hc, P), (2.0 * P) ** -0.5)
    d_skip = nrm(ks[14], (L, SSM_WIDTH), 1.0)
    w_glu = nrm(ks[15], (L, SSM_WIDTH, SSM_WIDTH), SSM_WIDTH ** -0.5)
    b_glu = nrm(ks[16], (L, SSM_WIDTH), 0.02)
    g_ssm_out = 1.0 + nrm(ks[17], (L, SSM_WIDTH), 0.02)
    g_ret_norm = 1.0 + nrm(ks[18], (L, RET_WIDTH), 0.02)
    w_out = nrm(ks[19], (L, MIX_WIDTH, D), MIX_WIDTH ** -0.5)
    g_mlp = 1.0 + nrm(ks[20], (L, D), 0.02)
    w_up = nrm(ks[21], (L, D, D_FF), D ** -0.5)
    w_down = nrm(ks[22], (L, D_FF, D), D_FF ** -0.5)
    g_final = 1.0 + nrm(ks[23], (D,), 0.02)
    return {"x": x, "c": c, "positions": positions, "w_ada": w_ada, "b_ada": b_ada,
            "g_mix": g_mix, "w_in": w_in, "lam_re": lam_re, "lam_im": lam_im,
            "log_dt": log_dt, "b_re": b_re, "b_im": b_im, "c_re": c_re, "c_im": c_im,
            "d_skip": d_skip, "w_glu": w_glu, "b_glu": b_glu, "g_ssm_out": g_ssm_out,
            "g_ret_norm": g_ret_norm, "w_out": w_out, "g_mlp": g_mlp, "w_up": w_up,
            "w_down": w_down, "g_final": g_final}


def reference(x, c, positions, w_ada, b_ada, g_mix, w_in, lam_re, lam_im, log_dt,
              b_re, b_im, c_re, c_im, d_skip, w_glu, b_glu, g_ssm_out, g_ret_norm,
              w_out, g_mlp, w_up, w_down, g_final):
    split_points = [SSM_WIDTH + i * RET_WIDTH for i in range(4)]
    c_act = jax.nn.silu(c)
    for i in range(DEPTH):
        mod = (c_act @ w_ada[i] + b_ada[i])[:, None, :]
        shift1, scale1, gate1, shift2, scale2, gate2 = jnp.split(mod, 6, axis=-1)

        h = rmsnorm(x, g_mix[i]) * (1.0 + scale1) + shift1
        proj = h @ w_in[i]
        u, q, k, v, g = jnp.split(proj, split_points, axis=-1)
        ssm_out = s5_branch(u, lam_re[i], lam_im[i], log_dt[i], b_re[i], b_im[i],
                            c_re[i], c_im[i], d_skip[i], w_glu[i], b_glu[i], g_ssm_out[i])
        ret_out = retention_branch(q, k, v, g, positions, g_ret_norm[i])
        mixed = jnp.concatenate([ssm_out.astype(ret_out.dtype), ret_out], axis=-1)
        mixed = mixed.astype(x.dtype) @ w_out[i]
        x = x + gate1 * mixed

        h = rmsnorm(x, g_mlp[i]) * (1.0 + scale2) + shift2
        x = x + gate2 * (jnp.square(jax.nn.relu(h @ w_up[i])) @ w_down[i])
    return rmsnorm(x, g_final)
```

```cpp
#include <hip/hip_runtime.h>
#include <cstdio>
#include <cstdint>

constexpr int DM = 4096, NBATCH = 2, SEQ = 4096, MR = NBATCH * SEQ, DEPTH = 2;
constexpr int SSMW = 2048, RETW = 2048, NG = 128, NP = 64, RH = 8, RD = 256, RC = 128, NCH = SEQ / RC;
constexpr int DFF = 16384, INW = 10240, MODW = 6 * DM;
constexpr float EPS = 1e-6f;

namespace pg8 {
#define PG8_LAS __attribute__((address_space(3)))
typedef unsigned short bf16_t;
typedef short bf16x8 __attribute__((ext_vector_type(8)));
typedef float f32x4 __attribute__((ext_vector_type(4)));
typedef unsigned u32x4 __attribute__((ext_vector_type(4)));
constexpr int BM = 256, BK = 64, HALF = 128, HTB = HALF * BK * 2  , STAGE_BYTES = 8 * HTB, NXCD = 8, WGM = 8;

__host__ __device__ __forceinline__ int lds_byte(int r, int c) { const int st = (r >> 4) * 2 + (c >> 5), rr = r & 15, cc = c & 31, ob = rr * 64 + cc * 2; return st * 1024 + (ob ^ (((ob >> 9) & 1) << 5)); }
__host__ __device__ __forceinline__ void stage_rc(int b, int& R, int& C) { const int st = b / 1024, sb = b % 1024, swz = sb ^ (((sb >> 9) & 1) << 5); R = (st >> 1) * 16 + swz / 64; C = (st & 1) * 32 + (swz % 64) / 2; }
__host__ __device__ __forceinline__ int perm32(int rho) { const int n = rho >> 4, i = rho & 15; return 8 * (i >> 2) + 4 * n + (i & 3); }

struct Unit { int pm, pn; };
struct Gemm { const bf16_t* A; const bf16_t* Bt; int M, N, K; };

struct StaticOrder {
    int nM, nN, nwg, G, c;
    __host__ __device__ void init(int M, int N, int G_, int c_) { nM = M / BM; nN = N / BM; nwg = nM * nN; G = G_; c = c_; }
    __host__ __device__ bool next(int i, Unit& u) const {
        const long L = (long)i * G + c; if (L >= nwg) return false;
        int wgid = (int)L; { const int q = nwg / NXCD, r = nwg % NXCD, xcd = wgid % NXCD, off = wgid / NXCD; wgid = (xcd < r ? xcd * (q + 1) : r * (q + 1) + (xcd - r) * q) + off; }
        const int nig = WGM * nN, gid = wgid / nig, fm = gid * WGM, gsz = (nM - fm) < WGM ? (nM - fm) : WGM;
        u.pm = fm + ((wgid % nig) % gsz); u.pn = (wgid % nig) / gsz; return true;
    }
    __device__ __forceinline__ void a_ready(const Unit&) const {}
    __device__ __forceinline__ void done(const Unit&) const {}
};

__device__ __forceinline__ unsigned cvt_pk_bf16(float lo, float hi) { unsigned r; asm volatile("v_cvt_pk_bf16_f32 %0, %1, %2" : "=v"(r) : "v"(lo), "v"(hi)); return r; }
typedef float f32x2 __attribute__((ext_vector_type(2)));

template <class Epi, class Sched, bool ALIGN_EPI = false, bool SP2 = false>
__device__ __forceinline__ void gemm_phase(PG8_LAS unsigned char* lds, const Gemm g, const Sched& S, const Epi& E) {
    int tid_ = threadIdx.x; asm volatile("" : "+v"(tid_));
    const int tid = tid_ & 511, wid = __builtin_amdgcn_readfirstlane(tid >> 6), lane = tid & 63, wr = wid >> 2, wc = wid & 3, fr = lane & 15, fq = lane >> 4;
    const int K = g.K, nt = K / BK;
    unsigned voffA[2], voffB[2];
#pragma unroll
    for (int i = 0; i < 2; ++i) { int R, C; stage_rc(tid * 16 + i * 8192, R, C); const int Rb = Epi::PERM ? ((R & ~31) + perm32(R & 31)) : R;
        voffA[i] = (unsigned)(R * K + C) * 2u; voffB[i] = (unsigned)(Rb * K + C) * 2u; }
    const size_t kstep = (size_t)(BK * 2);
    const size_t hstep = (size_t)HALF * K * 2;
    const size_t tstep = 2 * hstep;
    const unsigned ldsw = (unsigned)wid * 1024u;
    const int aoff = lds_byte(wr * 64 + fr, fq * 8), boff = lds_byte(wc * 32 + fr, fq * 8);
#define PG8_SA(b, h) (((b) * 2 + (h)) * HTB)
#define PG8_SB(b, h) ((4 + (b) * 2 + (h)) * HTB)
#define PG8_STAGE(bufoff, gbase, voff) do { _Pragma("unroll") for (int _i = 0; _i < 2; ++_i) \
        __builtin_amdgcn_global_load_lds((const unsigned*)((const char*)(gbase) + (voff)[_i]), (PG8_LAS unsigned*)(lds + (bufoff) + ldsw + _i * 8192), 16, 0, 0); } while (0)
#define PG8_LDA(dst, b, h) do { _Pragma("unroll") for (int m = 0; m < 4; ++m) _Pragma("unroll") for (int k = 0; k < 2; ++k) dst[m][k] = *(const PG8_LAS bf16x8*)(lds + PG8_SA(b, h) + aoff + m * 2048 + k * 1024); } while (0)
#define PG8_LDB(dst, b, h) do { _Pragma("unroll") for (int n = 0; n < 2; ++n) _Pragma("unroll") for (int k = 0; k < 2; ++k) dst[n][k] = *(const PG8_LAS bf16x8*)(lds + PG8_SB(b, h) + boff + n * 2048 + k * 1024); } while (0)
#define PG8_MMA(ai, bj, At, Bt) do { __builtin_amdgcn_s_setprio(1); _Pragma("unroll") for (int m = 0; m < 4; ++m) _Pragma("unroll") for (int n = 0; n < 2; ++n) _Pragma("unroll") for (int k = 0; k < 2; ++k) \
        acc[ai][bj][m][n] = __builtin_amdgcn_mfma_f32_16x16x32_bf16(Bt[n][k], At[m][k], acc[ai][bj][m][n], 0, 0, 0); __builtin_amdgcn_s_setprio(0); } while (0)
#define PG8_WAIT_V(n) asm volatile("s_waitcnt vmcnt(" #n ")" ::: "memory")
#define PG8_WAIT_L(n) asm volatile("s_waitcnt lgkmcnt(" #n ")" ::: "memory")
#define PG8_BAR __builtin_amdgcn_s_barrier()
#define PG8_SCHED __builtin_amdgcn_sched_barrier(0)
    Unit cur, nxt; int ui = 0;
    if (!S.next(0, cur)) return;
    f32x4 acc[2][2][4][2];
#pragma unroll
    for (int a = 0; a < 2; ++a)
#pragma unroll
        for (int b = 0; b < 2; ++b)
#pragma unroll
            for (int m = 0; m < 4; ++m)
#pragma unroll
                for (int n = 0; n < 2; ++n) acc[a][b][m][n] = (f32x4){0.f, 0.f, 0.f, 0.f};
    bf16x8 At[4][2], B0[2][2], B1[2][2];
    const char* cA = (const char*)g.A + (size_t)cur.pm * tstep; const char* cB = (const char*)g.Bt + (size_t)cur.pn * tstep;
    S.a_ready(cur);
    if constexpr (SP2) {
        PG8_STAGE(PG8_SB(0, 0), cB, voffB); PG8_STAGE(PG8_SB(0, 1), cB + hstep, voffB); PG8_STAGE(PG8_SA(0, 0), cA, voffA); PG8_STAGE(PG8_SA(0, 1), cA + hstep, voffA);
        if (wr == 1) PG8_BAR;
        PG8_WAIT_V(2); PG8_BAR;
        PG8_STAGE(PG8_SB(1, 0), cB + kstep, voffB); PG8_STAGE(PG8_SA(1, 0), cA + kstep, voffA); PG8_STAGE(PG8_SB(1, 1), cB + hstep + kstep, voffB);
        PG8_WAIT_V(6); PG8_BAR;
    } else {
        PG8_STAGE(PG8_SB(0, 0), cB, voffB); PG8_STAGE(PG8_SA(0, 0), cA, voffA); PG8_STAGE(PG8_SB(0, 1), cB + hstep, voffB); PG8_STAGE(PG8_SA(0, 1), cA + hstep, voffA);
        if (wr == 1) PG8_BAR;
        PG8_WAIT_V(4); PG8_BAR;
        PG8_STAGE(PG8_SB(1, 0), cB + kstep, voffB); PG8_STAGE(PG8_SA(1, 0), cA + kstep, voffA); PG8_STAGE(PG8_SB(1, 1), cB + hstep + kstep, voffB);
        PG8_WAIT_V(6); PG8_BAR;
    }
    for (;;) {
        const bool has_next = S.next(ui + 1, nxt);
        const char* nA = has_next ? (const char*)g.A + (size_t)nxt.pm * tstep : cA; const char* nB = has_next ? (const char*)g.Bt + (size_t)nxt.pn * tstep : cB;
        for (int t = 0; t < nt; t += 2) {
            if constexpr (Epi::HOOK) { if (t == (nt >> 1)) E.hook(acc, ui, wr, fr); }
            const bool last = (t == nt - 2);
            const char* a1 = cA + (size_t)(t + 1) * kstep;
            const char* a2 = last ? nA : cA + (size_t)(t + 2) * kstep; const char* b2 = last ? nB : cB + (size_t)(t + 2) * kstep;
            const char* a3 = a2 + kstep; const char* b3 = b2 + kstep;
            if (last && has_next) S.a_ready(nxt);
            if constexpr (SP2) {
            PG8_LDB(B0, 0, 0); PG8_LDB(B1, 0, 1); PG8_SCHED; PG8_LDA(At, 0, 0); PG8_STAGE(PG8_SA(1, 1), a1 + hstep, voffA);
            PG8_WAIT_V(8); PG8_WAIT_L(0); PG8_BAR; PG8_MMA(0, 0, At, B0); PG8_MMA(0, 1, At, B1); PG8_BAR; PG8_SCHED;
            PG8_LDA(At, 0, 1); PG8_STAGE(PG8_SB(0, 0), b2, voffB); PG8_STAGE(PG8_SB(0, 1), b2 + hstep, voffB); PG8_STAGE(PG8_SA(0, 0), a2, voffA);
            PG8_WAIT_V(8); PG8_WAIT_L(0); PG8_BAR; PG8_MMA(1, 0, At, B0); PG8_MMA(1, 1, At, B1); PG8_BAR; PG8_SCHED;
            PG8_LDB(B0, 1, 0); PG8_LDB(B1, 1, 1); PG8_SCHED; PG8_LDA(At, 1, 0); PG8_STAGE(PG8_SA(0, 1), a2 + hstep, voffA);
            PG8_WAIT_V(8); PG8_WAIT_L(0); PG8_BAR; PG8_MMA(0, 0, At, B0); PG8_MMA(0, 1, At, B1); PG8_BAR; PG8_SCHED;
            PG8_LDA(At, 1, 1); PG8_STAGE(PG8_SB(1, 0), b3, voffB); PG8_STAGE(PG8_SB(1, 1), b3 + hstep, voffB); PG8_STAGE(PG8_SA(1, 0), a3, voffA);
            PG8_WAIT_V(8); PG8_WAIT_L(0); PG8_BAR; PG8_MMA(1, 0, At, B0); PG8_MMA(1, 1, At, B1); PG8_BAR; PG8_SCHED;
            } else {
            PG8_LDB(B0, 0, 0); PG8_SCHED; PG8_LDA(At, 0, 0); PG8_STAGE(PG8_SA(1, 1), a1 + hstep, voffA);
            PG8_WAIT_L(8); PG8_BAR; PG8_WAIT_L(0); PG8_MMA(0, 0, At, B0); PG8_BAR; PG8_SCHED;
            PG8_LDB(B1, 0, 1); PG8_STAGE(PG8_SB(0, 0), b2, voffB);
            PG8_BAR; PG8_WAIT_L(0); PG8_MMA(0, 1, At, B1); PG8_BAR;
            PG8_LDA(At, 0, 1); PG8_STAGE(PG8_SA(0, 0), a2, voffA);
            PG8_BAR; PG8_WAIT_L(0); PG8_MMA(1, 0, At, B0); PG8_BAR; PG8_SCHED;
            PG8_STAGE(PG8_SB(0, 1), b2 + hstep, voffB);
            PG8_WAIT_V(6); PG8_BAR; PG8_MMA(1, 1, At, B1); PG8_BAR;
            PG8_LDB(B0, 1, 0); PG8_SCHED; PG8_LDA(At, 1, 0); PG8_STAGE(PG8_SA(0, 1), a2 + hstep, voffA);
            PG8_WAIT_L(8); PG8_BAR; PG8_WAIT_L(0); PG8_MMA(0, 0, At, B0); PG8_BAR; PG8_SCHED;
            PG8_LDB(B1, 1, 1); PG8_STAGE(PG8_SB(1, 0), b3, voffB);
            PG8_BAR; PG8_WAIT_L(0); PG8_MMA(0, 1, At, B1); PG8_BAR;
            PG8_LDA(At, 1, 1); PG8_STAGE(PG8_SA(1, 0), a3, voffA);
            PG8_BAR; PG8_WAIT_L(0); PG8_MMA(1, 0, At, B0); PG8_BAR; PG8_SCHED;
            PG8_STAGE(PG8_SB(1, 1), b3 + hstep, voffB);
            PG8_WAIT_V(6); PG8_BAR; PG8_MMA(1, 1, At, B1); PG8_BAR;
            }
        }
        if constexpr (ALIGN_EPI) { if (wr == 0) PG8_BAR; }
        if constexpr (!Epi::AFTER_DRAIN) { E(acc, cur, wr, wc, fr, fq); S.done(cur); }
        if (!has_next) break;
#pragma unroll
        for (int a = 0; a < 2; ++a)
#pragma unroll
            for (int b = 0; b < 2; ++b)
#pragma unroll
                for (int m = 0; m < 4; ++m)
#pragma unroll
                    for (int n = 0; n < 2; ++n) acc[a][b][m][n] = (f32x4){0.f, 0.f, 0.f, 0.f};
        cur = nxt; cA = nA; cB = nB; ++ui;
        if constexpr (ALIGN_EPI) { if (wr == 1) PG8_BAR; }
    }
    PG8_WAIT_V(0);
    if constexpr (!ALIGN_EPI) { if (wr == 0) PG8_BAR; }
    PG8_BAR;
    if constexpr (Epi::AFTER_DRAIN) { E.fused(acc, cur, wr, wc, fr, fq, lds, wid, lane); S.done(cur); }
#undef PG8_SA
#undef PG8_SB
#undef PG8_STAGE
#undef PG8_LDA
#undef PG8_LDB
#undef PG8_MMA
#undef PG8_WAIT_V
#undef PG8_WAIT_L
#undef PG8_BAR
#undef PG8_SCHED
}
}


namespace pg8 {
typedef unsigned u32x2 __attribute__((ext_vector_type(2)));
__device__ __forceinline__ float sigmoid_f(float z) { return __builtin_amdgcn_rcpf(1.0f + __builtin_amdgcn_exp2f(-1.4426950408889634f * z)); }
__device__ __forceinline__ float bf_lo(unsigned w) { return __uint_as_float(w << 16); }
__device__ __forceinline__ float bf_hi(unsigned w) { return __uint_as_float(w & 0xffff0000u); }

struct EpiIn {
    static constexpr bool PERM = true, AFTER_DRAIN = false, HOOK = false;
    bf16_t* proj; const float* rope; const float* kdec;
    __device__ __forceinline__ void operator()(const f32x4 (&acc)[2][2][4][2], const Unit& u, int wr, int wc, int fr, int fq) const {
        const int seg = u.pn >> 3, hb = u.pn & 7;
        bf16_t* base = proj + (size_t)seg * ((size_t)MR * 2048) + hb * 256 + wc * 32 + 8 * fq;
        const int row0 = u.pm * BM + wr * 64 + fr, pi0 = 16 * wc + 4 * fq;
        const bool rot = (seg == 1) || (seg == 2);
#pragma unroll
        for (int ai = 0; ai < 2; ++ai)
#pragma unroll
            for (int m = 0; m < 4; ++m) {
                const int row = row0 + ai * HALF + m * 16;
                bf16_t* rowp = base + (size_t)row * 2048;
                float ks = 1.f; if (seg == 2) ks = kdec[hb * 128 + (row & 127)];
#pragma unroll
                for (int bj = 0; bj < 2; ++bj) {
                    f32x4 v0 = acc[ai][bj][m][0], v1 = acc[ai][bj][m][1];
                    if (rot) {
                        const float* rp = rope + ((size_t)row * 128 + 64 * bj + pi0) * 2;
                        const f32x4 r0 = *(const f32x4*)rp, r1 = *(const f32x4*)(rp + 4);
                        f32x4 w0, w1;
                        w0[0] = v0[0] * r0[0] - v0[1] * r0[1]; w0[1] = v0[0] * r0[1] + v0[1] * r0[0];
                        w0[2] = v0[2] * r0[2] - v0[3] * r0[3]; w0[3] = v0[2] * r0[3] + v0[3] * r0[2];
                        w1[0] = v1[0] * r1[0] - v1[1] * r1[1]; w1[1] = v1[0] * r1[1] + v1[1] * r1[0];
                        w1[2] = v1[2] * r1[2] - v1[3] * r1[3]; w1[3] = v1[2] * r1[3] + v1[3] * r1[2];
                        v0 = w0 * ks; v1 = w1 * ks;
                    }
                    u32x4 w; w.x = cvt_pk_bf16(v0[0], v0[1]); w.y = cvt_pk_bf16(v0[2], v0[3]); w.z = cvt_pk_bf16(v1[0], v1[1]); w.w = cvt_pk_bf16(v1[2], v1[3]);
                    *(u32x4*)(rowp + bj * HALF) = w;
                }
            }
    }
};
struct EpiGlu {
    static constexpr bool PERM = true, AFTER_DRAIN = false, HOOK = false;
    const bf16_t* yg; bf16_t* mixed; const float* bglu; const float* gout; float* ssqp;
    __device__ __forceinline__ void operator()(const f32x4 (&acc)[2][2][4][2], const Unit& u, int wr, int wc, int fr, int fq) const {
        const int row0 = u.pm * BM + wr * 64 + fr, col0 = u.pn * BM + wc * 32 + 8 * fq;
        f32x4 bv[2][2], gv[2][2];
#pragma unroll
        for (int bj = 0; bj < 2; ++bj)
#pragma unroll
            for (int n = 0; n < 2; ++n) { bv[bj][n] = *(const f32x4*)(bglu + col0 + bj * HALF + 4 * n); gv[bj][n] = *(const f32x4*)(gout + col0 + bj * HALF + 4 * n); }
#pragma unroll
        for (int ai = 0; ai < 2; ++ai)
#pragma unroll
            for (int m = 0; m < 4; ++m) {
                const int row = row0 + ai * HALF + m * 16; float s = 0.f;
#pragma unroll
                for (int bj = 0; bj < 2; ++bj) {
                    const u32x4 yv = *(const u32x4*)(yg + (size_t)row * 2048 + col0 + bj * HALF);
                    const f32x4 z0 = acc[ai][bj][m][0] + bv[bj][0], z1 = acc[ai][bj][m][1] + bv[bj][1];
                    f32x4 o0, o1;
                    o0[0] = bf_lo(yv.x) * sigmoid_f(z0[0]); o0[1] = bf_hi(yv.x) * sigmoid_f(z0[1]); o0[2] = bf_lo(yv.y) * sigmoid_f(z0[2]); o0[3] = bf_hi(yv.y) * sigmoid_f(z0[3]);
                    o1[0] = bf_lo(yv.z) * sigmoid_f(z1[0]); o1[1] = bf_hi(yv.z) * sigmoid_f(z1[1]); o1[2] = bf_lo(yv.w) * sigmoid_f(z1[2]); o1[3] = bf_hi(yv.w) * sigmoid_f(z1[3]);
                    s += (o0[0] * o0[0] + o0[1] * o0[1]) + (o0[2] * o0[2] + o0[3] * o0[3]) + (o1[0] * o1[0] + o1[1] * o1[1]) + (o1[2] * o1[2] + o1[3] * o1[3]);
                    o0 = o0 * gv[bj][0]; o1 = o1 * gv[bj][1];
                    u32x4 w; w.x = cvt_pk_bf16(o0[0], o0[1]); w.y = cvt_pk_bf16(o0[2], o0[3]); w.z = cvt_pk_bf16(o1[0], o1[1]); w.w = cvt_pk_bf16(o1[2], o1[3]);
                    *(u32x4*)(mixed + (size_t)row * 4096 + col0 + bj * HALF) = w;
                }
                s += __shfl_xor(s, 16); s += __shfl_xor(s, 32);
                if (fq == 0) ssqp[(size_t)row * 32 + u.pn * 4 + wc] = s;
            }
    }
};
template <bool HK> struct EpiRes {
    static constexpr bool PERM = false, AFTER_DRAIN = false, HOOK = HK;
    const float* xin; float* xout; const float* gate; const PG8_LAS float* rs;
    __device__ __forceinline__ void hook(f32x4 (&acc)[2][2][4][2], int ui, int wr, int fr) const {
#pragma unroll
        for (int ai = 0; ai < 2; ++ai)
#pragma unroll
            for (int m = 0; m < 4; ++m) { const float s = rs[(ui & 1) * 256 + ai * HALF + wr * 64 + m * 16 + fr];
#pragma unroll
                for (int bj = 0; bj < 2; ++bj)
#pragma unroll
                    for (int n = 0; n < 2; ++n) acc[ai][bj][m][n] = acc[ai][bj][m][n] * s; }
    }
    __device__ __forceinline__ void operator()(const f32x4 (&acc)[2][2][4][2], const Unit& u, int wr, int wc, int fr, int fq) const {
        const int row0 = u.pm * BM + wr * 64 + fr, col0 = u.pn * BM + wc * 32 + 4 * fq;
        const float* gp = gate + (size_t)(u.pm >> 4) * MODW + col0;
        f32x4 gv[2][2];
#pragma unroll
        for (int bj = 0; bj < 2; ++bj)
#pragma unroll
            for (int n = 0; n < 2; ++n) gv[bj][n] = *(const f32x4*)(gp + bj * HALF + n * 16);
#pragma unroll
        for (int ai = 0; ai < 2; ++ai)
#pragma unroll
            for (int m = 0; m < 4; ++m) { const size_t off = (size_t)(row0 + ai * HALF + m * 16) * DM + col0;
#pragma unroll
                for (int bj = 0; bj < 2; ++bj)
#pragma unroll
                    for (int n = 0; n < 2; ++n) { const f32x4 xi = *(const f32x4*)(xin + off + bj * HALF + n * 16);
                        *(f32x4*)(xout + off + bj * HALF + n * 16) = xi + gv[bj][n] * acc[ai][bj][m][n]; }
                asm volatile("" ::: "memory"); }
    }
};
struct EpiUp {
    static constexpr bool PERM = true, AFTER_DRAIN = false, HOOK = false;
    bf16_t* hid;
    __device__ __forceinline__ void operator()(const f32x4 (&acc)[2][2][4][2], const Unit& u, int wr, int wc, int fr, int fq) const {
        const int row0 = u.pm * BM + wr * 64 + fr, col0 = u.pn * BM + wc * 32 + 8 * fq;
#pragma unroll
        for (int ai = 0; ai < 2; ++ai)
#pragma unroll
            for (int m = 0; m < 4; ++m) { bf16_t* rowp = hid + (size_t)(row0 + ai * HALF + m * 16) * DFF + col0;
#pragma unroll
                for (int bj = 0; bj < 2; ++bj) { f32x4 v0 = acc[ai][bj][m][0], v1 = acc[ai][bj][m][1];
#pragma unroll
                    for (int j = 0; j < 4; ++j) { const float a = fmaxf(v0[j], 0.f), b = fmaxf(v1[j], 0.f); v0[j] = a * a; v1[j] = b * b; }
                    u32x4 w; w.x = cvt_pk_bf16(v0[0], v0[1]); w.y = cvt_pk_bf16(v0[2], v0[3]); w.z = cvt_pk_bf16(v1[0], v1[1]); w.w = cvt_pk_bf16(v1[2], v1[3]);
                    *(u32x4*)(rowp + bj * HALF) = w; } }
    }
};
}

constexpr int NWAVES = 8;
#ifndef MK_PER_PHASE
#define MK_PER_PHASE 0
#endif
constexpr size_t AL(size_t x) { return (x + 4095) & ~(size_t)4095; }
constexpr size_t WS_CTL = 0, CTL_ZERO_BYTES = 1u << 20;
constexpr size_t SZ_WIN = (size_t)INW * DM * 2, SZ_WGLU = (size_t)SSMW * SSMW * 2, SZ_WOUT = (size_t)DM * DM * 2, SZ_WUP = (size_t)DFF * DM * 2, SZ_WDOWN = SZ_WUP;
constexpr size_t WS_WIN = CTL_ZERO_BYTES, WS_WGLU = WS_WIN + 2 * SZ_WIN, WS_WOUT = WS_WGLU + 2 * SZ_WGLU, WS_WUP = WS_WOUT + 2 * SZ_WOUT, WS_WDOWN = WS_WUP + 2 * SZ_WUP;
constexpr size_t WS_ADAP = WS_WDOWN + 2 * SZ_WDOWN, SZ_ADAP = (size_t)DEPTH * 64 * NBATCH * MODW * 4;
constexpr size_t WS_MOD = WS_ADAP + SZ_ADAP, SZ_MOD = AL((size_t)DEPTH * NBATCH * MODW * 4);
constexpr size_t WS_ROPE = WS_MOD + SZ_MOD, SZ_ROPE = (size_t)MR * 128 * 8;
constexpr size_t WS_LAMB = WS_ROPE + SZ_ROPE, SZ_LAMB = AL((size_t)DEPTH * NG * NP * 8);
constexpr size_t WS_LAMT = WS_LAMB + SZ_LAMB;
constexpr size_t WS_BCAT = WS_LAMT + SZ_LAMB, SZ_BCAT = AL((size_t)DEPTH * NG * 128 * 16 * 2);
constexpr size_t WS_CCAT = WS_BCAT + SZ_BCAT;
constexpr size_t WS_DEC = WS_CCAT + SZ_BCAT, SZ_DEC = 16384;
constexpr size_t WS_HBUF = WS_DEC + SZ_DEC, SZ_HBUF = (size_t)MR * DM * 2;
constexpr size_t WS_PROJ = WS_HBUF + SZ_HBUF, SZ_PROJ1 = (size_t)MR * 2048 * 2;
constexpr size_t WS_YG = WS_PROJ + 5 * SZ_PROJ1;
constexpr size_t WS_MIXED = WS_YG + SZ_PROJ1;
constexpr size_t WS_SSQP = WS_MIXED + SZ_HBUF, SZ_SSQP = (size_t)MR * 32 * 4;
constexpr size_t WS_X = WS_SSQP + SZ_SSQP, SZ_X = (size_t)MR * DM * 4;
constexpr size_t WS_HID = WS_X + SZ_X, SZ_HID = (size_t)MR * DFF * 2;
constexpr size_t WS_KV = WS_HID + SZ_HID, SZ_KV = (size_t)NBATCH * RH * NCH * RD * RD * 4;
constexpr size_t WS_ST = WS_KV + SZ_KV, SZ_ST = SZ_KV / 2;
constexpr size_t WS_S5E = WS_ST + SZ_ST, SZ_S5E = (size_t)NBATCH * NG * NCH * 128 * 4;
constexpr size_t WS_S5C = WS_S5E + SZ_S5E;
constexpr size_t WS_END = WS_S5C + SZ_S5E;
constexpr int CW_BAR = 4096;
constexpr int RING_BYTES = 139264;
constexpr int RS_OFF = 131072;
constexpr int LDSCTL_OFF = RING_BYTES, MISC_OFF = LDSCTL_OFF + 320;
constexpr int LDS_BYTES = 147456;
static_assert(MISC_OFF + 128 <= LDS_BYTES, "LDS map");

#define GAS __attribute__((address_space(1)))
#define LAS __attribute__((address_space(3)))
typedef unsigned short bf16;
typedef unsigned v4u __attribute__((ext_vector_type(4)));
typedef unsigned v2u __attribute__((ext_vector_type(2)));
typedef float f32x4 __attribute__((ext_vector_type(4)));
typedef float f32x2 __attribute__((ext_vector_type(2)));
typedef float f32x16 __attribute__((ext_vector_type(16)));
typedef short bf16x8 __attribute__((ext_vector_type(8)));
typedef short s16x4 __attribute__((ext_vector_type(4)));
typedef short v4i16_t __attribute__((ext_vector_type(4)));
typedef GAS unsigned gu32;
#define RLX_AGENT __ATOMIC_RELAXED, __HIP_MEMORY_SCOPE_AGENT
#define LDS_WAIT() asm volatile("s_waitcnt lgkmcnt(0)" ::: "memory")
#define VM_WAIT() asm volatile("s_waitcnt vmcnt(0)" ::: "memory")
__device__ __forceinline__ unsigned f2bf(float f) { unsigned u = __builtin_bit_cast(unsigned, f); return (u + 0x7fffu + ((u >> 16) & 1u)) >> 16; }
__device__ __forceinline__ unsigned pk2(float lo, float hi) { return pg8::cvt_pk_bf16(lo, hi); }
__device__ __forceinline__ float bflo(unsigned w) { return __uint_as_float(w << 16); }
__device__ __forceinline__ float bfhi(unsigned w) { return __uint_as_float(w & 0xffff0000u); }
__device__ __forceinline__ s16x4 vtr(const LAS unsigned char* p) { return __builtin_bit_cast(s16x4, __builtin_amdgcn_ds_read_tr16_b64_v4i16((LAS v4i16_t*)p)); }
__device__ __forceinline__ bf16x8 cat8(s16x4 a, s16x4 b) { bf16x8 r; r[0] = a[0]; r[1] = a[1]; r[2] = a[2]; r[3] = a[3]; r[4] = b[0]; r[5] = b[1]; r[6] = b[2]; r[7] = b[3]; return r; }
__device__ __forceinline__ float wave_sum(float v) {
#pragma unroll
    for (int o = 1; o < 64; o <<= 1) v += __shfl_xor(v, o);
    return v;
}
#define MFMA16(a, b, c) __builtin_amdgcn_mfma_f32_16x16x32_bf16((a), (b), (c), 0, 0, 0)
#define MFMA32(a, b, c) __builtin_amdgcn_mfma_f32_32x32x16_bf16((a), (b), (c), 0, 0, 0)


#define XB_TMO      128
#define XB_XCNT(j)  (256  + 64 * (j))
#define XB_XSUB(j)  (1280 + 64 * (j))
#define XB_XGEN(j)  (2304 + 64 * (j))
#define XB_TOP      3328
#define XB_TOPGEN   3392
#define XCD_BAR_WORDS 3456
#define XB_SPIN_CAP (1u << 18)

__device__ __forceinline__ unsigned xb_ld(unsigned* p)              { return __hip_atomic_load(p, __ATOMIC_RELAXED, __HIP_MEMORY_SCOPE_AGENT); }
__device__ __forceinline__ unsigned xb_add(unsigned* p, unsigned v) { return __hip_atomic_fetch_add(p, v, __ATOMIC_RELAXED, __HIP_MEMORY_SCOPE_AGENT); }
__device__ __forceinline__ unsigned xb_xcc_id() { return (unsigned)__builtin_amdgcn_s_getreg((3 << 11) | 20) & 0xFu; }
#define XB_SPIN(cond, bar) do { unsigned _sp = 0; while (cond) { __builtin_amdgcn_s_sleep(1); \
    if ((++_sp & 255u) == 0u) { if (xb_ld(&(bar)[XB_TMO])) break; if (_sp > XB_SPIN_CAP) { atomicAdd(&(bar)[XB_TMO], 1u); break; } } } } while (0)

struct XcdBarrier {
    unsigned* bar; unsigned x;
    volatile LAS unsigned* st;
};

__device__ __forceinline__ XcdBarrier xcd_barrier_post(unsigned* bar, volatile LAS unsigned* st) {
    XcdBarrier b; b.bar = bar; b.x = xb_xcc_id(); b.st = st;
    if (threadIdx.x == 0) (void)xb_add(&bar[XB_XCNT(b.x)], 1u);
    return b;
}
__device__ __forceinline__ void xcd_barrier_complete(unsigned* bar, unsigned x, unsigned& nloc, unsigned& nx) {
    const unsigned G = gridDim.x * gridDim.y * gridDim.z;
    unsigned sum, cnt, mine, sp = 0u;
    for (;;) {
        sum = 0u; cnt = 0u; mine = 0u;
#pragma unroll
        for (unsigned j = 0; j < 16; ++j) { const unsigned c = xb_ld(&bar[XB_XCNT(j)]); sum += c; cnt += (c > 0u) ? 1u : 0u; mine = (j == x) ? c : mine; }
        if (sum == G) break;
        __builtin_amdgcn_s_sleep(1);
        if ((++sp & 255u) == 0u) { if (xb_ld(&bar[XB_TMO])) break; if (sp > XB_SPIN_CAP) { atomicAdd(&bar[XB_TMO], 1u); break; } }
    }
    nloc = mine > 0u ? mine : 1u; nx = cnt > 0u ? cnt : 1u;
}

__device__ __forceinline__ void xcd_barrier(const XcdBarrier& b) {
    asm volatile("s_waitcnt vmcnt(0)" ::: "memory");
    __syncthreads();
    if (threadIdx.x == 0) {
        unsigned* bar = b.bar;
        __builtin_amdgcn_s_waitcnt(0);
        unsigned nloc = b.st[0], nx = b.st[1];
        if (nloc == 0u) { xcd_barrier_complete(bar, b.x, nloc, nx); b.st[0] = nloc; b.st[1] = nx; }
        const unsigned old = xb_add(&bar[XB_XSUB(b.x)], 1u);
        const unsigned gen = old / nloc;
        if (old + 1u == (gen + 1u) * nloc) {
            __builtin_amdgcn_fence(__ATOMIC_RELEASE, "agent");
            asm volatile("s_waitcnt vmcnt(0)" ::: "memory");
            const unsigned og = xb_add(&bar[XB_TOP], 1u);
            const unsigned tg = og / nx;
            if (og + 1u == (tg + 1u) * nx) xb_add(&bar[XB_TOPGEN], 1u);
            else XB_SPIN(xb_ld(&bar[XB_TOPGEN]) == tg, bar);
            __builtin_amdgcn_fence(__ATOMIC_ACQUIRE, "agent");
            xb_add(&bar[XB_XGEN(b.x)], 1u);
            asm volatile("s_waitcnt vmcnt(0)" ::: "memory");
        } else {
            XB_SPIN(xb_ld(&bar[XB_XGEN(b.x)]) == gen, bar);
            __builtin_amdgcn_fence(__ATOMIC_ACQUIRE, "agent");
            asm volatile("s_waitcnt vmcnt(0)" ::: "memory");
        }
    }
    __syncthreads();
}

#define CAS __attribute__((address_space(4)))
__device__ __forceinline__ const void* karg_ptr(int byte_off) {
    int o = byte_off; asm volatile("" : "+s"(o));
    const CAS char* kp = (const CAS char*)__builtin_amdgcn_kernarg_segment_ptr();
    return *(const void* const CAS*)(kp + o);
}
#define INP(i) ((const float*)karg_ptr(8 * (i)))
#define WSP() ((unsigned char*)karg_ptr(8 * 25))
#define OUTP() ((float*)karg_ptr(8 * 24))
__device__ __forceinline__ void sincos_d(double x, double& s, double& c) {
    const double q = rint(x * 0.63661977236758134308);
    double r = fma(-q, 1.57079632679489655800e+00, x); r = fma(-q, 6.12323399573676603587e-17, r);
    const int k = (int)((long long)q & 3);
    const double r2 = r * r;
    const double sp = r * (1.0 + r2 * (-1.0 / 6.0 + r2 * (1.0 / 120.0 + r2 * (-1.0 / 5040.0 + r2 * (1.0 / 362880.0 + r2 * (-1.0 / 39916800.0 + r2 * (1.0 / 6227020800.0)))))));
    const double cp = 1.0 + r2 * (-0.5 + r2 * (1.0 / 24.0 + r2 * (-1.0 / 720.0 + r2 * (1.0 / 40320.0 + r2 * (-1.0 / 3628800.0 + r2 * (1.0 / 479001600.0 + r2 * (-1.0 / 87178291200.0)))))));
    s = (k == 0) ? sp : (k == 1) ? cp : (k == 2) ? -sp : -cp;
    c = (k == 0) ? cp : (k == 1) ? -sp : (k == 2) ? -cp : sp;
}
__device__ __forceinline__ int permqk(int n) {
    if (n < 2048 || n >= 6144) return n;
    const int r = n - 2048, i = r & 255;
    return 2048 + (r & ~255) + 2 * (i & 127) + (i >> 7);
}
__device__ __forceinline__ void tr_tile_load(const float* W, int N, int k0, int n0, int lane, f32x4 (&v)[16]) {
    const int l5 = lane & 31, hf = lane >> 5, lr = l5 >> 3, lc = (l5 & 7) + 8 * hf;
    const float* wp = W + (size_t)(k0 + lr) * N + n0 + 4 * lc;
#pragma unroll
    for (int i = 0; i < 16; ++i) v[i] = __builtin_nontemporal_load((const f32x4*)(wp + (size_t)(4 * i) * N));
}
__device__ __forceinline__ void tr_tile_store(const f32x4 (&v)[16], bf16* WT, int K, int k0, int n0, bool pq, LAS float* scr, int lane) {
    const int l5 = lane & 31, hf = lane >> 5, lr = l5 >> 3, lc = (l5 & 7) + 8 * hf;
    LAS float* sw = scr + lr * 65 + 4 * lc;
#pragma unroll
    for (int i = 0; i < 16; ++i) { sw[(4 * i) * 65 + 0] = v[i].x; sw[(4 * i) * 65 + 1] = v[i].y; sw[(4 * i) * 65 + 2] = v[i].z; sw[(4 * i) * 65 + 3] = v[i].w; }
    LDS_WAIT(); asm volatile("" ::: "memory");
    const int nn = l5 >> 2, kc = (l5 & 3) + 4 * hf;
#pragma unroll
    for (int j = 0; j < 8; ++j) { const int n = nn + 8 * j; const LAS float* s = scr + (8 * kc) * 65 + n;
        v4u o; o.x = pk2(s[0 * 65], s[1 * 65]); o.y = pk2(s[2 * 65], s[3 * 65]); o.z = pk2(s[4 * 65], s[5 * 65]); o.w = pk2(s[6 * 65], s[7 * 65]);
        const int orow = pq ? permqk(n0 + n) : (n0 + n);
        *(GAS v4u*)(WT + (size_t)orow * K + k0 + 8 * kc) = o; }
    LDS_WAIT(); asm volatile("" ::: "memory");
}
template <bool PQK>
__device__ __forceinline__ void p0_transpose_item(const float* W, int K, int N, bf16* WT, LAS float* scr, int item, int lane) {
    const int nblk = N / 64, kb = item / nblk, nb = item % nblk, k0 = 64 * kb, n0 = 64 * nb;
    f32x4 v[16]; tr_tile_load(W, N, k0, n0, lane, v); tr_tile_store(v, WT, K, k0, n0, PQK, scr, lane);
}
__device__ __forceinline__ void p0_ada_item(const float* c, const float* w_ada, float* adap, int item, int lane) {
    const int l = item / 6144, r = item % 6144, ks = r / 96, nc = r % 96;
    const float c0 = c[64 * ks + lane], c1 = c[DM + 64 * ks + lane];
    const float a0 = c0 * pg8::sigmoid_f(c0), a1 = c1 * pg8::sigmoid_f(c1);
    const float* wp = w_ada + ((size_t)l * DM + 64 * ks) * MODW + 256 * nc + 4 * lane;
    f32x4 s0 = {0.f, 0.f, 0.f, 0.f}, s1 = {0.f, 0.f, 0.f, 0.f};
#pragma unroll 16
    for (int k = 0; k < 64; ++k) {
        const f32x4 w = __builtin_nontemporal_load((const f32x4*)(wp + (size_t)k * MODW));
        const float b0 = __builtin_bit_cast(float, __builtin_amdgcn_readlane(__builtin_bit_cast(int, a0), k));
        const float b1 = __builtin_bit_cast(float, __builtin_amdgcn_readlane(__builtin_bit_cast(int, a1), k));
        s0 = s0 + w * b0; s1 = s1 + w * b1;
    }
    float* op = adap + (((size_t)l * 64 + ks) * 2) * MODW + 256 * nc + 4 * lane;
    *(f32x4*)op = s0; *(f32x4*)(op + MODW) = s1;
}
__device__ __forceinline__ void p0_rope_item(const int* positions, float* rope, int m, int lane) {
    const float pos = (float)positions[m];
#pragma unroll
    for (int t = 0; t < 2; ++t) { const int i = lane + 64 * t;
        const float inv = (float)exp2(-(double)i * (13.287712379549449 / 128.0));
        const float ang = pos * inv;
        double s, c; sincos_d((double)ang, s, c);
        *(f32x2*)(rope + ((size_t)m * 128 + i) * 2) = (f32x2){(float)c, (float)s}; }
}
__device__ __forceinline__ void p0_dec_item(float* dec, int lane) {
#pragma unroll
    for (int h = 0; h < 8; ++h) { const double lg = log2(1.0 - exp2(-5.0 - (double)h));
#pragma unroll
        for (int t = 0; t < 2; ++t) { const int j = lane + 64 * t;
            dec[h * 128 + j] = (float)(exp2((double)(127 - j) * lg) * 0.0625);
            dec[1024 + h * 128 + j] = (float)exp2((double)(j - 127) * lg); }
        if (lane == 0) dec[2048 + h] = (float)exp2(128.0 * lg); }
}
struct S5In { const float *lam_re, *lam_im, *log_dt, *b_re, *b_im, *c_re, *c_im; };
__device__ __forceinline__ void p0_s5_item(const S5In& P, f32x2* lamb, f32x2* lamt, bf16* bcat, bf16* ccat, int item, int lane) {
    const int lg = item, p = lane;
    const double lr = P.lam_re[lg * 64 + p], li = P.lam_im[lg * 64 + p], dt = exp((double)P.log_dt[lg]);
    double s, c; sincos_d(li * dt, s, c); const double er = exp(lr * dt), lbr = er * c, lbi = er * s;
    double s2, c2; sincos_d(128.0 * li * dt, s2, c2); const double e2 = exp(128.0 * lr * dt);
    lamb[lg * 64 + p] = (f32x2){(float)lbr, (float)lbi}; lamt[lg * 64 + p] = (f32x2){(float)(e2 * c2), (float)(e2 * s2)};
    const double nr = lbr - 1.0, ni = lbi, den = lr * lr + li * li, cr = (nr * lr + ni * li) / den, ci = (ni * lr - nr * li) / den;
    const float* br = P.b_re + ((size_t)lg * 64 + p) * 16; const float* bi = P.b_im + ((size_t)lg * 64 + p) * 16;
    bf16* o_re = bcat + ((size_t)lg * 128 + p) * 16; bf16* o_im = bcat + ((size_t)lg * 128 + 64 + p) * 16;
#pragma unroll
    for (int h = 0; h < 16; ++h) { const double xr = br[h], xi = bi[h]; o_re[h] = (bf16)f2bf((float)(cr * xr - ci * xi)); o_im[h] = (bf16)f2bf((float)(cr * xi + ci * xr)); }
#pragma unroll
    for (int h = 0; h < 16; ++h) { ccat[((size_t)lg * 16 + h) * 128 + p] = (bf16)f2bf(P.c_re[((size_t)lg * 16 + h) * 64 + p]); ccat[((size_t)lg * 16 + h) * 128 + 64 + p] = (bf16)f2bf(-P.c_im[((size_t)lg * 16 + h) * 64 + p]); }
}

__device__ __forceinline__ void norm_rows_bf16(const float* x, bf16* out, const float* g, const float* shift, const float* scale, int gw, int NGW, int lane) {
    for (int m = gw; m < MR; m += NGW) {
        const f32x4* xr = (const f32x4*)(x + (size_t)m * DM) + lane; const int b = m >> 12;
        f32x4 v[16]; float ss = 0.f;
#pragma unroll
        for (int j = 0; j < 16; ++j) { v[j] = xr[64 * j]; ss += (v[j].x * v[j].x + v[j].y * v[j].y) + (v[j].z * v[j].z + v[j].w * v[j].w); }
        const float rstd = 1.0f / sqrtf(wave_sum(ss) * (1.0f / DM) + EPS);
        const f32x4* gp = (const f32x4*)g + lane; const f32x4* sh = (const f32x4*)(shift + (size_t)b * MODW) + lane; const f32x4* sc = (const f32x4*)(scale + (size_t)b * MODW) + lane;
        v2u* op = (v2u*)(out + (size_t)m * DM) + lane;
#pragma unroll
        for (int j = 0; j < 16; ++j) { const f32x4 o = v[j] * rstd * gp[64 * j] * (1.0f + sc[64 * j]) + sh[64 * j]; v2u w; w.x = pk2(o.x, o.y); w.y = pk2(o.z, o.w); op[64 * j] = w; }
    }
}
__device__ __forceinline__ void norm_rows_f32(const float* x, float* out, const float* g, int gw, int NGW, int lane) {
    for (int m = gw; m < MR; m += NGW) {
        const f32x4* xr = (const f32x4*)(x + (size_t)m * DM) + lane;
        f32x4 v[16]; float ss = 0.f;
#pragma unroll
        for (int j = 0; j < 16; ++j) { v[j] = xr[64 * j]; ss += (v[j].x * v[j].x + v[j].y * v[j].y) + (v[j].z * v[j].z + v[j].w * v[j].w); }
        const float rstd = 1.0f / sqrtf(wave_sum(ss) * (1.0f / DM) + EPS);
        const f32x4* gp = (const f32x4*)g + lane; f32x4* op = (f32x4*)(out + (size_t)m * DM) + lane;
#pragma unroll
        for (int j = 0; j < 16; ++j) op[64 * j] = v[j] * rstd * gp[64 * j];
    }
}

__device__ __forceinline__ float gelu_tanh(float x) { const float z = 0.7978845608028654f * (x + 0.044715f * x * x * x); return x * __builtin_amdgcn_rcpf(1.0f + __builtin_amdgcn_exp2f(-2.8853900817779268f * z)); }
#define S5_SCAN(RE, IM, LR, LI, SR, SI) do { _Pragma("unroll") for (int r_ = 0; r_ < 16; ++r_) { \
        const float nr_ = fmaf(LR, SR, fmaf(-(LI), SI, RE[r_])), ni_ = fmaf(LR, SI, fmaf(LI, SR, IM[r_])); SR = nr_; SI = ni_; RE[r_] = nr_; IM[r_] = ni_; } } while (0)
#define S5_FIX(RE, IM, LR, LI, CR, CI) do { _Pragma("unroll") for (int r_ = 0; r_ < 16; ++r_) { \
        const float nr_ = LR * CR - LI * CI, ni_ = LR * CI + LI * CR; CR = nr_; CI = ni_; RE[r_] += nr_; IM[r_] += ni_; } } while (0)
struct RiderNone { static constexpr bool ON = false;
    __device__ __forceinline__ bool load(int, f32x4 (&)[16]) const { return false; }
    __device__ __forceinline__ void store(int, const f32x4 (&)[16], LAS float*) const {} };
constexpr int TT_IN = (DM / 64) * (INW / 64), TT_GLU = (SSMW / 64) * (SSMW / 64), TT_OUT = (DM / 64) * (DM / 64), TT_UP = (DM / 64) * (DFF / 64), TT_DOWN = (DFF / 64) * (DM / 64);
constexpr int RIDE_S1 = 3, RIDE_S3 = 10, RIDE_TILES = (RIDE_S1 + RIDE_S3) * 2048;
template <int SEQ> __device__ __forceinline__ bool seq_decode(int r, const float*& W, bf16*& WT, int& K, int& N, int& k0, int& n0, bool& pq) {
    constexpr int TOTAL = SEQ == 0 ? TT_IN + TT_GLU + TT_OUT + TT_UP + TT_DOWN : TT_UP + TT_DOWN;
    pq = false; if (r >= TOTAL) return false;
    unsigned char* ws = WSP();
    if (SEQ == 0) {
        if (r < TT_IN) { W = INP(6) + (size_t)DM * INW; WT = (bf16*)(ws + WS_WIN) + (size_t)INW * DM; K = DM; N = INW; k0 = 64 * (r / (INW / 64)); n0 = 64 * (r % (INW / 64)); pq = true; return true; } r -= TT_IN;
        if (r < TT_GLU) { W = INP(15) + (size_t)SSMW * SSMW; WT = (bf16*)(ws + WS_WGLU) + (size_t)SSMW * SSMW; K = SSMW; N = SSMW; k0 = 64 * (r / (SSMW / 64)); n0 = 64 * (r % (SSMW / 64)); return true; } r -= TT_GLU;
        if (r < TT_OUT) { W = INP(19) + (size_t)DM * DM; WT = (bf16*)(ws + WS_WOUT) + (size_t)DM * DM; K = DM; N = DM; k0 = 64 * (r / (DM / 64)); n0 = 64 * (r % (DM / 64)); return true; } r -= TT_OUT;
    }
    constexpr int L = SEQ;
    if (r < TT_UP) { W = INP(21) + (size_t)L * DM * DFF; WT = (bf16*)(ws + WS_WUP) + (size_t)L * DFF * DM; K = DM; N = DFF; k0 = 64 * (r / (DFF / 64)); n0 = 64 * (r % (DFF / 64)); return true; } r -= TT_UP;
    W = INP(22) + (size_t)L * DFF * DM; WT = (bf16*)(ws + WS_WDOWN) + (size_t)L * DM * DFF; K = DFF; N = DM; k0 = 64 * (r / (DM / 64)); n0 = 64 * (r % (DM / 64)); return true;
}
template <int SEQ> struct RiderConv { static constexpr bool ON = true;
    int gw, NGW, lane, base, quota;
    __device__ __forceinline__ bool load(int slot, f32x4 (&v)[16]) const {
        const float* W; bf16* WT; int K, N, k0, n0; bool pq; if (slot >= quota || !seq_decode<SEQ>(gw + NGW * (base + slot), W, WT, K, N, k0, n0, pq)) return false;
        tr_tile_load(W, N, k0, n0, lane, v); return true; }
    __device__ __forceinline__ void store(int slot, const f32x4 (&v)[16], LAS float* scr) const {
        const float* W; bf16* WT; int K, N, k0, n0; bool pq; if (!seq_decode<SEQ>(gw + NGW * (base + slot), W, WT, K, N, k0, n0, pq)) return;
        tr_tile_store(v, WT, K, k0, n0, pq, scr, lane); }
    __device__ __forceinline__ void finish(int done, LAS float* scr) const { for (int sl = done; sl < quota; ++sl) { f32x4 tv[16]; if (load(sl, tv)) store(sl, tv, scr); } }
};
__device__ __forceinline__ float bcast_lo(float x) { const unsigned u = __float_as_uint(x); auto t = __builtin_amdgcn_permlane32_swap(u, u, false, false); return __uint_as_float(t[0]); }
__device__ __forceinline__ float bcast_hi(float x) { const unsigned u = __float_as_uint(x); auto t = __builtin_amdgcn_permlane32_swap(u, u, false, false); return __uint_as_float(t[1]); }
template <int PASS, class Rider = RiderNone>
__device__ __forceinline__ void s5_unit(const bf16* U, const f32x2* lamb, const bf16* bcat, const bf16* ccat, const float* dskip, float* s5e, const float* s5c, bf16* yg,
                                        int layer, int b, int g, int c, LAS unsigned char* wl, int lane, const Rider& RD = Rider(), int slot0 = 0) {
    const int r32 = lane & 31, hh = lane >> 5, g4 = lane >> 4, i16 = lane & 15, q4 = i16 >> 2, p4 = lane & 3;
    const int lg = layer * NG + g;
    const f32x2 la0 = lamb[lg * 64 + r32], la1 = lamb[lg * 64 + 32 + r32];
    const float l0r = la0.x, l0i = la0.y, l1r = la1.x, l1i = la1.y;
    bf16x8 bfr[4];
#pragma unroll
    for (int nb = 0; nb < 4; ++nb) bfr[nb] = *(const bf16x8*)(bcat + ((size_t)lg * 128 + 32 * nb + r32) * 16 + 8 * hh);
    float x0r = 0.f, x0i = 0.f, x1r = 0.f, x1i = 0.f;
    const size_t sidx = (((size_t)b * NG + g) * NCH + c) * 128;
    float m0r = 1.f, m0i = 0.f, m1r = 1.f, m1i = 0.f;
    bf16x8 cfr[4];
    if (PASS == 3) { x0r = s5c[sidx + r32]; x0i = s5c[sidx + 64 + r32]; x1r = s5c[sidx + 32 + r32]; x1i = s5c[sidx + 96 + r32];
#pragma unroll
        for (int ks = 0; ks < 4; ++ks) cfr[ks] = *(const bf16x8*)(ccat + ((size_t)lg * 16 + i16) * 128 + 32 * ks + 8 * g4);
    } else { m0r = l0r; m0i = l0i; m1r = l1r; m1i = l1i;
#pragma unroll
        for (int k = 0; k < 4; ++k) { const float a = m0r * m0r - m0i * m0i, bb = 2.f * m0r * m0i; m0r = a; m0i = bb; const float a1 = m1r * m1r - m1i * m1i, b1 = 2.f * m1r * m1i; m1r = a1; m1i = b1; } }
    const int tokperm = 16 * ((r32 >> 2) & 1) + (r32 & 3) + 4 * (r32 >> 3);
    const size_t row0 = (size_t)b * SEQ + (size_t)c * RC;
    const f32x16 z16 = {0.f, 0.f, 0.f, 0.f, 0.f, 0.f, 0.f, 0.f, 0.f, 0.f, 0.f, 0.f, 0.f, 0.f, 0.f, 0.f};
    const bf16* ua = U + (row0 + tokperm) * 2048 + g * 16 + 8 * hh;
    const bf16* ue = U + (row0 + i16) * 2048 + g * 16 + 4 * g4;
    f32x4 dk = {0.f, 0.f, 0.f, 0.f}; if (PASS == 3) dk = *(const f32x4*)(dskip + layer * SSMW + g * 16 + 4 * g4);
    bf16x8 a_nxt = *(const bf16x8*)ua;
#pragma unroll
    for (int blk = 0; blk < 4; ++blk) {
        const bf16x8 a = a_nxt;
        if (blk < 3) a_nxt = *(const bf16x8*)(ua + (size_t)(blk + 1) * 32 * 2048);
        f32x4 tv[16]; bool tvalid = false;
        if constexpr (Rider::ON) { tvalid = RD.load(slot0 + blk, tv); __builtin_amdgcn_sched_barrier(0); }
        v2u uv0 = {0u, 0u}, uv1 = {0u, 0u};
        if (PASS == 3) { uv0 = *(const v2u*)(ue + (size_t)(32 * blk) * 2048); uv1 = *(const v2u*)(ue + (size_t)(32 * blk + 16) * 2048); }
        f32x16 d0 = MFMA32(a, bfr[0], z16), d1 = MFMA32(a, bfr[1], z16), d2 = MFMA32(a, bfr[2], z16), d3 = MFMA32(a, bfr[3], z16);
        float s0r = hh ? 0.f : x0r, s0i = hh ? 0.f : x0i, s1r = hh ? 0.f : x1r, s1i = hh ? 0.f : x1i;
        S5_SCAN(d0, d2, l0r, l0i, s0r, s0i);
        S5_SCAN(d1, d3, l1r, l1i, s1r, s1i);
        float c0r = bcast_lo(s0r), c0i = bcast_lo(s0i), c1r = bcast_lo(s1r), c1i = bcast_lo(s1i);
        if (PASS == 1) {
            const float e0r = m0r * c0r - m0i * c0i + s0r, e0i = m0r * c0i + m0i * c0r + s0i, e1r = m1r * c1r - m1i * c1i + s1r, e1i = m1r * c1i + m1i * c1r + s1i;
            x0r = bcast_hi(e0r); x0i = bcast_hi(e0i); x1r = bcast_hi(e1r); x1i = bcast_hi(e1i);
        } else {
            c0r = hh ? c0r : 0.f; c0i = hh ? c0i : 0.f; c1r = hh ? c1r : 0.f; c1i = hh ? c1i : 0.f;
            S5_FIX(d0, d2, l0r, l0i, c0r, c0i);
            S5_FIX(d1, d3, l1r, l1i, c1r, c1i);
            x0r = bcast_hi(d0[15]); x0i = bcast_hi(d2[15]); x1r = bcast_hi(d1[15]); x1i = bcast_hi(d3[15]);
            {
                v4u w;
                LAS unsigned char* base = wl + 32 * hh;
#define S5_PUT(D, ROW) do { LAS unsigned char* p_ = base + (ROW) * 96; \
                w.x = pk2(D[0], D[1]); w.y = pk2(D[2], D[3]); w.z = pk2(D[4], D[5]); w.w = pk2(D[6], D[7]); *(LAS v4u*)p_ = w; \
                w.x = pk2(D[8], D[9]); w.y = pk2(D[10], D[11]); w.z = pk2(D[12], D[13]); w.w = pk2(D[14], D[15]); *(LAS v4u*)(p_ + 16) = w; } while (0)
                S5_PUT(d0, r32); S5_PUT(d1, 32 + r32); S5_PUT(d2, 64 + r32); S5_PUT(d3, 96 + r32);
#undef S5_PUT
            }
            LDS_WAIT();
#pragma unroll
            for (int tb = 0; tb < 2; ++tb) {
                f32x4 y = {0.f, 0.f, 0.f, 0.f};
#pragma unroll
                for (int ks = 0; ks < 4; ++ks) {
                    const LAS unsigned char* ap = wl + (32 * ks + 8 * g4 + q4) * 96 + 32 * tb + 8 * p4;
                    const s16x4 t0 = vtr(ap), t1 = vtr(ap + 4 * 96);
                    y = MFMA16(cfr[ks], cat8(t0, t1), y);
                }
                const size_t off = (row0 + 32 * blk + 16 * tb + i16) * 2048 + g * 16 + 4 * g4;
                const v2u uv = tb ? uv1 : uv0;
                const float y0 = gelu_tanh(y[0] + dk[0] * bflo(uv.x)), y1 = gelu_tanh(y[1] + dk[1] * bfhi(uv.x)), y2 = gelu_tanh(y[2] + dk[2] * bflo(uv.y)), y3 = gelu_tanh(y[3] + dk[3] * bfhi(uv.y));
                v2u o; o.x = pk2(y0, y1); o.y = pk2(y2, y3);
                *(v2u*)(yg + off) = o;
            }
            LDS_WAIT();
        }
        if constexpr (Rider::ON) { if (tvalid) RD.store(slot0 + blk, tv, (LAS float*)wl); }
    }
    if (PASS == 1 && hh == 0) { s5e[sidx + r32] = x0r; s5e[sidx + 64 + r32] = x0i; s5e[sidx + 32 + r32] = x1r; s5e[sidx + 96 + r32] = x1i; }
}
__device__ __forceinline__ void s5_carry(const f32x2* lamt, const float* s5e, float* s5c, int layer, int bg, int lane) {
    const int g = bg & (NG - 1); const f32x2 lt = lamt[(layer * NG + g) * 64 + lane];
    const size_t base = (size_t)bg * NCH * 128;
    float er[NCH], ei[NCH];
#pragma unroll
    for (int c = 0; c < NCH; ++c) { er[c] = s5e[base + c * 128 + lane]; ei[c] = s5e[base + c * 128 + 64 + lane]; }
    float xr = 0.f, xi = 0.f;
#pragma unroll
    for (int c = 0; c < NCH; ++c) { s5c[base + c * 128 + lane] = xr; s5c[base + c * 128 + 64 + lane] = xi;
        const float nr = lt.x * xr - lt.y * xi + er[c], ni = lt.x * xi + lt.y * xr + ei[c]; xr = nr; xi = ni; }
}

constexpr int RSTR = 544;
__device__ __forceinline__ void ret_stage(const bf16* src, size_t row0, int h, LAS unsigned char* img, int tid) {
#pragma unroll
    for (int i = 0; i < 8; ++i) { const int idx = tid + 512 * i, row = idx >> 5, ch = idx & 31;
        const v4u v = *(const v4u*)(src + (row0 + row) * 2048 + h * 256 + ch * 8); *(LAS v4u*)(img + row * RSTR + ch * 16) = v; }
}
__device__ __forceinline__ void ret_kv_unit(const bf16* Kp, const bf16* Vp, bf16* kv, int unit, LAS unsigned char* lds, int tid, int wave, int lane) {
    const int bh = unit >> 5, c = unit & 31, b = bh >> 3, h = bh & 7;
    const size_t row0 = (size_t)b * SEQ + (size_t)c * RC;
    LAS unsigned char* kimg = lds; LAS unsigned char* vimg = lds + 128 * RSTR;
    ret_stage(Kp, row0, h, kimg, tid); ret_stage(Vp, row0, h, vimg, tid);
    __syncthreads();
    const int r32 = lane & 31, hh = lane >> 5, blk = (lane >> 4) & 1, q4 = (lane & 15) >> 2, p4 = lane & 3;
    const int lo = (8 * hh + q4) * RSTR + 32 * blk + 8 * p4;
    bf16x8 af[8];
#pragma unroll
    for (int ks = 0; ks < 8; ++ks) { const LAS unsigned char* ap = vimg + lo + (16 * ks) * RSTR + 64 * wave; af[ks] = cat8(vtr(ap), vtr(ap + 4 * RSTR)); }
    bf16* op = kv + (size_t)unit * 65536 + (size_t)wave * 8192 + (((r32 >> 4) * 64 + ((r32 >> 3) & 1) * 32 + 4 * hh) * 8 + (r32 & 7));
#pragma unroll
    for (int dt = 0; dt < 8; ++dt) {
        f32x16 acc = {0.f, 0.f, 0.f, 0.f, 0.f, 0.f, 0.f, 0.f, 0.f, 0.f, 0.f, 0.f, 0.f, 0.f, 0.f, 0.f};
#pragma unroll
        for (int ks = 0; ks < 8; ++ks) { const LAS unsigned char* bp = kimg + lo + (16 * ks) * RSTR + 64 * dt; acc = MFMA32(af[ks], cat8(vtr(bp), vtr(bp + 4 * RSTR)), acc); }
#pragma unroll
        for (int r = 0; r < 16; ++r) op[dt * 1024 + ((r & 3) + 8 * (r >> 2)) * 8] = (bf16)f2bf(acc[r]);
    }
    __syncthreads();
}
__device__ __forceinline__ void ret_scan_item(const bf16* kv, bf16* st, const float* dec, int item) {
    const int bh = item >> 14, e4 = item & 16383, h = bh & 7; const float g128 = dec[2048 + h];
    const v2u* kp = (const v2u*)(kv + (size_t)bh * NCH * 65536) + e4; v2u* sp = (v2u*)(st + (size_t)bh * NCH * 65536) + e4;
    f32x4 s = {0.f, 0.f, 0.f, 0.f};
#pragma unroll 8
    for (int c = 0; c < NCH; ++c) { const v2u kw = kp[(size_t)c * 16384]; const f32x4 k = {bflo(kw.x), bfhi(kw.x), bflo(kw.y), bfhi(kw.y)};
        v2u w; w.x = pk2(s.x, s.y); w.y = pk2(s.z, s.w); sp[(size_t)c * 16384] = w; s = (s + k) * g128; }
}
constexpr int QSTR = 528, PSTR = 272, R3_P = 69632, R3_RED = 104448;
__device__ __forceinline__ void ret_out_unit(const bf16* Qp, const bf16* Kp, const bf16* Vp, const bf16* Gp, const bf16* st, const float* dec, const float* gnorm, bf16* mixed,
                                             int unit, LAS unsigned char* lds, int tid, int wave, int lane) {
    const int bh = unit >> 5, c = unit & 31, b = bh >> 3, h = bh & 7;
    const size_t row0 = (size_t)b * SEQ + (size_t)c * RC;
    const int r32 = lane & 31, hh = lane >> 5, i16 = lane & 15, g4 = lane >> 4, blk = g4 & 1, q4 = i16 >> 2, p4 = lane & 3;
    bf16x8 sfr[16];
    { const bf16* sp = st + (size_t)unit * 65536 + (size_t)wave * 8192 + lane * 8;
#pragma unroll
      for (int ks = 0; ks < 16; ++ks) sfr[ks] = *(const bf16x8*)(sp + 512 * ks); }
#pragma unroll
    for (int i = 0; i < 8; ++i) { const int idx = tid + 512 * i, row = idx >> 5, ch = idx & 31;
        const v4u v = *(const v4u*)(Qp + (row0 + row) * 2048 + h * 256 + ch * 8); *(LAS v4u*)(lds + row * QSTR + ch * 16) = v; }
    __syncthreads();
    {
        bf16x8 qa[8];
        { const LAS unsigned char* qp = lds + (16 * wave + i16) * QSTR + 16 * g4;
#pragma unroll
          for (int ks = 0; ks < 8; ++ks) qa[ks] = *(const LAS bf16x8*)(qp + 64 * ks); }
        const bf16* kp = Kp + (row0 + i16) * 2048 + h * 256 + 8 * g4;
        LAS unsigned char* pw = lds + R3_P + (16 * wave + 4 * g4) * PSTR + 2 * i16;
#define R3_LD8(D, P) do { _Pragma("unroll") for (int ks_ = 0; ks_ < 8; ++ks_) D[ks_] = *(const bf16x8*)((P) + 32 * ks_); } while (0)
        bf16x8 ka[8], kb[8];
        R3_LD8(ka, kp);
#pragma unroll
        for (int mt = 0; mt < 8; ++mt) {
            if (mt > wave) break;
            f32x4 s = {0.f, 0.f, 0.f, 0.f};
            constexpr int dummy_ = 0; (void)dummy_;
            const int nx = (mt + 1 < 8) ? mt + 1 : 7;
            if (mt & 1) { R3_LD8(ka, kp + (size_t)nx * 16 * 2048);
                __builtin_amdgcn_sched_barrier(0);
#pragma unroll
                for (int ks = 0; ks < 8; ++ks) s = MFMA16(qa[ks], kb[ks], s); }
            else { R3_LD8(kb, kp + (size_t)nx * 16 * 2048);
                __builtin_amdgcn_sched_barrier(0);
#pragma unroll
                for (int ks = 0; ks < 8; ++ks) s = MFMA16(qa[ks], ka[ks], s); }
            if (mt == wave) {
#pragma unroll
                for (int r = 0; r < 4; ++r) if (i16 > 4 * g4 + r) s[r] = 0.f;
            }
#pragma unroll
            for (int r = 0; r < 4; ++r) *(LAS bf16*)(pw + r * PSTR + 32 * mt) = (bf16)f2bf(s[r]);
        }
        if (!(wave & 1)) {
#pragma unroll
            for (int r = 0; r < 4; ++r) *(LAS bf16*)(pw + r * PSTR + 32 * (wave + 1)) = (bf16)0;
        }
#undef R3_LD8
    }
    v4u vreg[8];
#pragma unroll
    for (int i = 0; i < 8; ++i) { const int idx = tid + 512 * i, row = idx >> 5, ch = idx & 31; vreg[i] = *(const v4u*)(Vp + (row0 + row) * 2048 + h * 256 + ch * 8); }
    __syncthreads();
    f32x16 acc[4];
#pragma unroll
    for (int nb = 0; nb < 4; ++nb) acc[nb] = (f32x16){0.f, 0.f, 0.f, 0.f, 0.f, 0.f, 0.f, 0.f, 0.f, 0.f, 0.f, 0.f, 0.f, 0.f, 0.f, 0.f};
    { const LAS unsigned char* qb = lds + r32 * QSTR + 16 * hh;
#pragma unroll
      for (int ks = 0; ks < 16; ++ks) {
#pragma unroll
          for (int nb = 0; nb < 4; ++nb) acc[nb] = MFMA32(sfr[ks], *(const LAS bf16x8*)(qb + nb * 32 * QSTR + 32 * ks), acc[nb]);
      } }
    __syncthreads();
#pragma unroll
    for (int i = 0; i < 8; ++i) { const int idx = tid + 512 * i, row = idx >> 5, ch = idx & 31; *(LAS v4u*)(lds + row * RSTR + ch * 16) = vreg[i]; }
    __syncthreads();
    {
        bf16x8 af[8];
        const int lo = (8 * hh + q4) * RSTR + 32 * blk + 8 * p4;
#pragma unroll
        for (int ks = 0; ks < 8; ++ks) { const LAS unsigned char* ap = lds + lo + (16 * ks) * RSTR + 64 * wave; af[ks] = cat8(vtr(ap), vtr(ap + 4 * RSTR)); }
        const LAS unsigned char* pb = lds + R3_P + r32 * PSTR + 16 * hh;
#pragma unroll
        for (int nb = 0; nb < 4; ++nb) {
#pragma unroll
            for (int ks = 0; ks < 8; ++ks) if (ks <= 2 * nb + 1) acc[nb] = MFMA32(af[ks], *(const LAS bf16x8*)(pb + nb * 32 * PSTR + 32 * ks), acc[nb]);
        }
    }
    const int e0 = 32 * wave + 4 * hh;
    f32x4 nv[4];
#pragma unroll
    for (int qd = 0; qd < 4; ++qd) nv[qd] = *(const f32x4*)(gnorm + h * 256 + e0 + 8 * qd);
    v4u greg[8];
    { const bf16* gp = Gp + (row0 + (lane >> 2)) * 2048 + h * 256 + 32 * wave + 8 * (lane & 3);
#pragma unroll
      for (int i = 0; i < 8; ++i) greg[i] = *(const v4u*)(gp + (size_t)(16 * i) * 2048); }
    LAS unsigned char* gw = lds + wave * 10240;
    LAS float* red = (LAS float*)(lds + R3_RED);
    float mu[4], rs[4];
#pragma unroll
    for (int nb = 0; nb < 4; ++nb) { const float sc = dec[1024 + h * 128 + 32 * nb + r32]; float s = 0.f;
#pragma unroll
        for (int r = 0; r < 16; ++r) { acc[nb][r] *= sc; s += acc[nb][r]; }
        s += __shfl_xor(s, 32);
        if (hh == 0) red[wave * 128 + 32 * nb + r32] = s; }
    __syncthreads();
#pragma unroll
    for (int i = 0; i < 8; ++i) *(LAS v4u*)(gw + (16 * i + (lane >> 2)) * 80 + (lane & 3) * 16) = greg[i];
#pragma unroll
    for (int nb = 0; nb < 4; ++nb) { float s = 0.f;
#pragma unroll
        for (int w = 0; w < 8; ++w) s += red[w * 128 + 32 * nb + r32];
        mu[nb] = s * (1.0f / 256.0f); float q = 0.f;
#pragma unroll
        for (int r = 0; r < 16; ++r) { acc[nb][r] -= mu[nb]; q += acc[nb][r] * acc[nb][r]; }
        q += __shfl_xor(q, 32);
        if (hh == 0) red[1024 + wave * 128 + 32 * nb + r32] = q; }
    __syncthreads();
#pragma unroll
    for (int nb = 0; nb < 4; ++nb) { float q = 0.f;
#pragma unroll
        for (int w = 0; w < 8; ++w) q += red[1024 + w * 128 + 32 * nb + r32];
        rs[nb] = 1.0f / sqrtf(q * (1.0f / 256.0f) + EPS); }
#pragma unroll
    for (int nb = 0; nb < 4; ++nb) {
        LAS unsigned char* pq = gw + (32 * nb + r32) * 80 + 8 * hh;
#pragma unroll
        for (int qd = 0; qd < 4; ++qd) {
            const v2u gv = *(const LAS v2u*)(pq + 16 * qd);
            const float g0 = bflo(gv.x), g1 = bfhi(gv.x), g2 = bflo(gv.y), g3 = bfhi(gv.y);
            const float o0 = acc[nb][4 * qd + 0] * rs[nb] * nv[qd][0] * (g0 * pg8::sigmoid_f(g0)), o1 = acc[nb][4 * qd + 1] * rs[nb] * nv[qd][1] * (g1 * pg8::sigmoid_f(g1));
            const float o2 = acc[nb][4 * qd + 2] * rs[nb] * nv[qd][2] * (g2 * pg8::sigmoid_f(g2)), o3 = acc[nb][4 * qd + 3] * rs[nb] * nv[qd][3] * (g3 * pg8::sigmoid_f(g3));
            v2u w; w.x = pk2(o0, o1); w.y = pk2(o2, o3); *(LAS v2u*)(pq + 16 * qd) = w;
        }
    }
    LDS_WAIT();
    { bf16* op = mixed + (row0 + (lane >> 2)) * 4096 + 2048 + h * 256 + 32 * wave + 8 * (lane & 3);
#pragma unroll
      for (int i = 0; i < 8; ++i) { const v4u o = *(const LAS v4u*)(gw + (16 * i + (lane >> 2)) * 80 + (lane & 3) * 16); *(v4u*)(op + (size_t)(16 * i) * 4096) = o; } }
    __syncthreads();
}

struct Args { const float* in[24]; float* out; unsigned char* ws; int ph_lo, ph_hi; };
#ifndef NLAYER_LOOP
#define NLAYER_LOOP DEPTH
#endif
constexpr int PH_LAYER0 = 2, PH_PER_LAYER = 10, PH_FINAL = PH_LAYER0 + DEPTH * PH_PER_LAYER, PH_COUNT = PH_FINAL + 1;

#if MK_PER_PHASE
#define GRID_BAR() do { } while (0)
#else
#define GRID_BAR() xcd_barrier(bar)
#endif
#ifndef PHMASK
#define PHMASK 0x1fff
#endif
#define EN(j) (((PHMASK) >> (j)) & 1)
#define IN(k) (lo <= (k) && (k) < hi)
#define SEAM(k) do { if (IN(k) && IN((k) + 1)) GRID_BAR(); } while (0)
#define PHASE_IDS() int tid_ = threadIdx.x; asm volatile("" : "+v"(tid_)); const int tid = tid_ & 511, lane = tid & 63, wave = __builtin_amdgcn_readfirstlane(tid >> 6); \
    const int gw = vcu * NWAVES + wave  , gwT = wave * G + vcu  ; (void)gw; (void)gwT; (void)lane; (void)tid
#define PH_ARGS const int G, const int bx, const int vcu, const int NGW, LAS unsigned char* lds
#define PH_PASS G, bx, vcu, NGW, lds
constexpr size_t WS_DUMMY = WS_END;
template <int layer, int SUB> __device__ __forceinline__ void ph_norm(PH_ARGS) {
    PHASE_IDS(); unsigned char* ws = WSP(); const float* modl = (const float*)(ws + WS_MOD) + (size_t)layer * NBATCH * MODW;
    const float* xcur = (layer == 0 && SUB == 0) ? INP(0) : (const float*)(ws + WS_X);
    norm_rows_bf16(xcur, (bf16*)(ws + WS_HBUF), INP(SUB == 0 ? 5 : 20) + (size_t)layer * DM, modl + (3 * SUB) * DM, modl + (3 * SUB + 1) * DM, gw, NGW, lane);
}
template <int layer> __device__ __forceinline__ void ph_gemm_in(PH_ARGS) {
    PHASE_IDS(); unsigned char* ws = WSP();
    pg8::Gemm g{(const bf16*)(ws + WS_HBUF), (const bf16*)(ws + WS_WIN) + (size_t)layer * INW * DM, MR, INW, DM}; pg8::StaticOrder S; S.init(MR, INW, G, bx);
    pg8::EpiIn E{(bf16*)(ws + WS_PROJ), (const float*)(ws + WS_ROPE), (const float*)(ws + WS_DEC)};
    pg8::gemm_phase<pg8::EpiIn, pg8::StaticOrder, true, true>(lds, g, S, E);
}
template <int layer> __device__ __forceinline__ void ph_local(PH_ARGS) {
    PHASE_IDS(); unsigned char* ws = WSP(); const bf16* proj = (const bf16*)(ws + WS_PROJ);
    { RiderConv<layer> RD; RD.gw = gw; RD.NGW = 2048; RD.lane = lane; RD.base = 0; RD.quota = (G == 256) ? RIDE_S1 : 0; int slot = 0;
      for (int k = vcu; k < 1024; k += G, slot += 4) { const int b = k >> 9, rem = k & 511, c = rem >> 4, g = (rem & 15) * 8 + wave;
          s5_unit<1, RiderConv<layer>>(proj, (const f32x2*)(ws + WS_LAMB), (const bf16*)(ws + WS_BCAT), (const bf16*)(ws + WS_CCAT), nullptr, (float*)(ws + WS_S5E), nullptr, nullptr, layer, b, g, c, lds + wave * 16640, lane, RD, slot); }
      RD.finish(slot, (LAS float*)(lds + wave * 16640));
      if (G != 256) for (int t = gw; t < RIDE_TILES; t += NGW) {
          const float* W; bf16* WT; int K, N, k0, n0; bool pq; f32x4 tv[16];
          if (seq_decode<layer>(t, W, WT, K, N, k0, n0, pq)) { tr_tile_load(W, N, k0, n0, lane, tv); tr_tile_store(tv, WT, K, k0, n0, pq, (LAS float*)(lds + wave * 16640), lane); } } }
    __syncthreads();
    for (int u = vcu; u < NBATCH * RH * NCH; u += G) ret_kv_unit(proj + (size_t)2 * MR * 2048, proj + (size_t)3 * MR * 2048, (bf16*)(ws + WS_KV), u, lds, tid, wave, lane);
}
template <int layer> __device__ __forceinline__ void ph_carry(PH_ARGS) {
    PHASE_IDS(); unsigned char* ws = WSP();
    for (int bg = gwT; bg < NBATCH * NG; bg += NGW) s5_carry((const f32x2*)(ws + WS_LAMT), (const float*)(ws + WS_S5E), (float*)(ws + WS_S5C), layer, bg, lane);
    for (int it = gw * 64 + lane; it < NBATCH * RH * 16384; it += NGW * 64) ret_scan_item((const bf16*)(ws + WS_KV), (bf16*)(ws + WS_ST), (const float*)(ws + WS_DEC), it);
}
template <int layer, int MODE = 0> __device__ __forceinline__ void ph_outputs(PH_ARGS) {
    PHASE_IDS(); unsigned char* ws = WSP(); const bf16* proj = (const bf16*)(ws + WS_PROJ);
    if (MODE != 2) { const float* dsk = INP(14);
      RiderConv<layer> RD; RD.gw = gw; RD.NGW = 2048; RD.lane = lane; RD.base = RIDE_S1; RD.quota = (G == 256) ? RIDE_S3 : 0; int slot = 0;
      for (int k = vcu; k < 1024; k += G, slot += 4) { const int b = k >> 9, rem = k & 511, c = rem >> 4, g = (rem & 15) * 8 + wave;
          s5_unit<3, RiderConv<layer>>(proj, (const f32x2*)(ws + WS_LAMB), (const bf16*)(ws + WS_BCAT), (const bf16*)(ws + WS_CCAT), dsk, nullptr, (const float*)(ws + WS_S5C), (bf16*)(ws + WS_YG), layer, b, g, c, lds + wave * 16640, lane, RD, slot); }
      RD.finish(slot, (LAS float*)(lds + wave * 16640)); }
    __syncthreads();
    if (MODE != 1) { const float* gn = INP(18) + (size_t)layer * RETW;
      for (int u = vcu; u < NBATCH * RH * NCH; u += G)
        ret_out_unit(proj + (size_t)1 * MR * 2048, proj + (size_t)2 * MR * 2048, proj + (size_t)3 * MR * 2048, proj + (size_t)4 * MR * 2048, (const bf16*)(ws + WS_ST), (const float*)(ws + WS_DEC), gn, (bf16*)(ws + WS_MIXED), u, lds, tid, wave, lane); }
}
template <int layer> __device__ __forceinline__ void ph_glu(PH_ARGS) {
    PHASE_IDS(); unsigned char* ws = WSP();
    pg8::Gemm g{(const bf16*)(ws + WS_YG), (const bf16*)(ws + WS_WGLU) + (size_t)layer * SSMW * SSMW, MR, SSMW, SSMW}; pg8::StaticOrder S; S.init(MR, SSMW, G, bx);
    pg8::EpiGlu E{(const bf16*)(ws + WS_YG), (bf16*)(ws + WS_MIXED), INP(16) + (size_t)layer * SSMW, INP(17) + (size_t)layer * SSMW, (float*)(ws + WS_SSQP)};
    pg8::gemm_phase<pg8::EpiGlu, pg8::StaticOrder, true, true>(lds, g, S, E);
}
template <int layer, bool DUMMY> __device__ __forceinline__ void ph_out(PH_ARGS) {
    PHASE_IDS(); unsigned char* ws = WSP();
    pg8::Gemm g{(const bf16*)(ws + WS_MIXED), (const bf16*)(ws + WS_WOUT) + (size_t)layer * DM * DM, MR, DM, DM}; pg8::StaticOrder S; S.init(MR, DM, G, bx);
    { pg8::Unit u; const int ui = tid >> 8; LAS float* rs = (LAS float*)(lds + RS_OFF); const float* ssqp = (const float*)(ws + WS_SSQP);
      if (S.next(ui, u)) { const f32x4* pp = (const f32x4*)(ssqp + (size_t)(u.pm * 256 + (tid & 255)) * 32); f32x4 s = pp[0];
#pragma unroll
          for (int j = 1; j < 8; ++j) s = s + pp[j];
          rs[tid] = 1.0f / sqrtf(((s.x + s.y) + (s.z + s.w)) * (1.0f / SSMW) + EPS); }
      __syncthreads(); }
    const float* xcur = (layer == 0) ? INP(0) : (const float*)(ws + WS_X);
    pg8::EpiRes<true> E{xcur, (float*)(ws + (DUMMY ? WS_DUMMY : WS_X)), (const float*)(ws + WS_MOD) + (size_t)layer * NBATCH * MODW + 2 * DM, (const LAS float*)(lds + RS_OFF)};
    pg8::gemm_phase<pg8::EpiRes<true>, pg8::StaticOrder, true, true>(lds, g, S, E);
}
template <int layer> __device__ __forceinline__ void ph_up(PH_ARGS) {
    PHASE_IDS(); unsigned char* ws = WSP();
    pg8::Gemm g{(const bf16*)(ws + WS_HBUF), (const bf16*)(ws + WS_WUP) + (size_t)layer * DFF * DM, MR, DFF, DM}; pg8::StaticOrder S; S.init(MR, DFF, G, bx);
    pg8::EpiUp E{(bf16*)(ws + WS_HID)};
    pg8::gemm_phase<pg8::EpiUp, pg8::StaticOrder, true, true>(lds, g, S, E);
}
template <int layer, bool DUMMY> __device__ __forceinline__ void ph_down(PH_ARGS) {
    PHASE_IDS(); unsigned char* ws = WSP();
    pg8::Gemm g{(const bf16*)(ws + WS_HID), (const bf16*)(ws + WS_WDOWN) + (size_t)layer * DM * DFF, MR, DM, DFF}; pg8::StaticOrder S; S.init(MR, DM, G, bx);
    pg8::EpiRes<false> E{(const float*)(ws + WS_X), (float*)(ws + (DUMMY ? WS_DUMMY : WS_X)), (const float*)(ws + WS_MOD) + (size_t)layer * NBATCH * MODW + 5 * DM, (const LAS float*)(lds + RS_OFF)};
    pg8::gemm_phase<pg8::EpiRes<false>, pg8::StaticOrder, true, true>(lds, g, S, E);
}
__device__ __forceinline__ void ph_prologue(PH_ARGS) {
    PHASE_IDS(); unsigned char* ws = WSP();
    LAS float* scr = (LAS float*)(lds + wave * 16640);
    constexpr int N_ADA = DEPTH * 64 * 96;
    constexpr int T_IN = TT_IN, T_GLU = TT_GLU, T_OUT = TT_OUT;
    constexpr int N_L0 = T_IN + T_GLU + T_OUT;
    constexpr int N_SQ0 = TT_IN + TT_GLU + TT_OUT + TT_UP + TT_DOWN - RIDE_TILES, N_SQ1 = TT_UP + TT_DOWN - RIDE_TILES;
    constexpr int N_TR = N_L0 + N_SQ0 + N_SQ1, N_ROPE = MR, N_S5 = DEPTH * NG, N_ITEMS = N_ADA + N_TR + N_ROPE + N_S5 + 1;
    for (int it = gw; it < N_ITEMS; it += NGW) {
        int r = it;
        if (r < N_ADA) { p0_ada_item(INP(1), INP(3), (float*)(ws + WS_ADAP), r, lane); continue; } r -= N_ADA;
        if (r < N_TR) {
            if (r < T_IN) { p0_transpose_item<true>(INP(6), DM, INW, (bf16*)(ws + WS_WIN), scr, r, lane); continue; } r -= T_IN;
            if (r < T_GLU) { p0_transpose_item<false>(INP(15), SSMW, SSMW, (bf16*)(ws + WS_WGLU), scr, r, lane); continue; } r -= T_GLU;
            if (r < T_OUT) { p0_transpose_item<false>(INP(19), DM, DM, (bf16*)(ws + WS_WOUT), scr, r, lane); continue; } r -= T_OUT;
            const float* W; bf16* WT; int K, N, k0, n0; bool pq; f32x4 tv[16];
            if (r < N_SQ0) { if (seq_decode<0>(RIDE_TILES + r, W, WT, K, N, k0, n0, pq)) { tr_tile_load(W, N, k0, n0, lane, tv); tr_tile_store(tv, WT, K, k0, n0, pq, scr, lane); } continue; } r -= N_SQ0;
            if (seq_decode<1>(RIDE_TILES + r, W, WT, K, N, k0, n0, pq)) { tr_tile_load(W, N, k0, n0, lane, tv); tr_tile_store(tv, WT, K, k0, n0, pq, scr, lane); } continue;
        } r -= N_TR;
        if (r < N_ROPE) { p0_rope_item((const int*)INP(2), (float*)(ws + WS_ROPE), r, lane); continue; } r -= N_ROPE;
        if (r < N_S5) { S5In sp; sp.lam_re = INP(7); sp.lam_im = INP(8); sp.log_dt = INP(9); sp.b_re = INP(10); sp.b_im = INP(11); sp.c_re = INP(12); sp.c_im = INP(13);
            p0_s5_item(sp, (f32x2*)(ws + WS_LAMB), (f32x2*)(ws + WS_LAMT), (bf16*)(ws + WS_BCAT), (bf16*)(ws + WS_CCAT), r, lane); continue; }
        p0_dec_item((float*)(ws + WS_DEC), lane);
    }
}
__device__ __forceinline__ void ph_mod(PH_ARGS) {
    PHASE_IDS(); unsigned char* ws = WSP(); const float* b_ada = INP(4); const float* adap = (const float*)(ws + WS_ADAP); float* mod = (float*)(ws + WS_MOD);
    for (int i = gw * 64 + lane; i < DEPTH * NBATCH * (MODW / 4); i += NGW * 64) {
        const int l = i / (NBATCH * (MODW / 4)), r = i % (NBATCH * (MODW / 4)), b = r / (MODW / 4), n4 = r % (MODW / 4);
        f32x4 s = *((const f32x4*)(b_ada + (size_t)l * MODW) + n4);
        const f32x4* pp = (const f32x4*)(adap + (((size_t)l * 64) * 2 + b) * MODW) + n4;
#pragma unroll 8
        for (int ks = 0; ks < 64; ++ks) s = s + pp[(size_t)ks * 2 * (MODW / 4)];
        *((f32x4*)(mod + ((size_t)l * NBATCH + b) * MODW) + n4) = s;
    }
}
__device__ __forceinline__ void ph_final(PH_ARGS) { PHASE_IDS(); unsigned char* ws = WSP(); norm_rows_f32((const float*)(ws + WS_X), OUTP(), INP(23), gw, NGW, lane); }
#ifndef REPMASK
#define REPMASK 0
#endif
#define REP(j) (((REPMASK) >> (j)) & 1)
template <int layer>
__device__ __forceinline__ void layer_phases(const int lo, const int hi, PH_ARGS, const XcdBarrier& bar) {
    constexpr int pb = PH_LAYER0 + layer * PH_PER_LAYER;
    if (EN(0) && IN(pb + 0)) { if (REP(0)) ph_norm<layer, 0>(PH_PASS); ph_norm<layer, 0>(PH_PASS); }
    SEAM(pb + 0);
    if (EN(1) && IN(pb + 1)) { if (REP(1)) ph_gemm_in<layer>(PH_PASS); ph_gemm_in<layer>(PH_PASS); }
    SEAM(pb + 1);
    if (EN(2) && IN(pb + 2)) { if (REP(2)) { ph_local<layer>(PH_PASS); __syncthreads(); } ph_local<layer>(PH_PASS); }
    SEAM(pb + 2);
    if (EN(3) && IN(pb + 3)) { if (REP(3)) ph_carry<layer>(PH_PASS); ph_carry<layer>(PH_PASS); }
    SEAM(pb + 3);
    if (EN(4) && IN(pb + 4)) { if (REP(4)) { ph_outputs<layer>(PH_PASS); __syncthreads(); } if (REP(13)) { ph_outputs<layer, 1>(PH_PASS); __syncthreads(); } if (REP(14)) { ph_outputs<layer, 2>(PH_PASS); __syncthreads(); } ph_outputs<layer>(PH_PASS); }
    SEAM(pb + 4);
    if (EN(5) && IN(pb + 5)) { if (REP(5)) ph_glu<layer>(PH_PASS); ph_glu<layer>(PH_PASS); }
    SEAM(pb + 5);
    if (EN(6) && IN(pb + 6)) { if (REP(6)) { ph_out<layer, true>(PH_PASS); __syncthreads(); } ph_out<layer, false>(PH_PASS); }
    SEAM(pb + 6);
    if (EN(7) && IN(pb + 7)) { if (REP(7)) ph_norm<layer, 1>(PH_PASS); ph_norm<layer, 1>(PH_PASS); }
    SEAM(pb + 7);
    if (EN(8) && IN(pb + 8)) { if (REP(8)) ph_up<layer>(PH_PASS); ph_up<layer>(PH_PASS); }
    SEAM(pb + 8);
    if (EN(9) && IN(pb + 9)) { if (REP(9)) ph_down<layer, true>(PH_PASS); ph_down<layer, false>(PH_PASS); }
    SEAM(pb + 9);
}

__global__ void __launch_bounds__(NWAVES * 64, 2) trunk_fwd(Args args) {
    extern __shared__ __attribute__((aligned(16))) unsigned char lds_raw[];
    LAS unsigned char* lds = (LAS unsigned char*)lds_raw;
    volatile LAS unsigned* MISC = (volatile LAS unsigned*)(lds + MISC_OFF);
    const int G = gridDim.x; const int bx = blockIdx.x; const int vcu = (G % 8 == 0) ? (bx % 8) * (G / 8) + bx / 8 : bx;
    const int NGW = G * NWAVES;
    for (int u = threadIdx.x; u < (LDS_BYTES - LDSCTL_OFF) / 4; u += NWAVES * 64) ((LAS unsigned*)(lds + LDSCTL_OFF))[u] = 0u;
    __syncthreads();
#if MK_PER_PHASE
    XcdBarrier bar; bar.bar = nullptr; bar.x = 0; bar.st = nullptr;
#else
    XcdBarrier bar = xcd_barrier_post((unsigned*)(args.ws + WS_CTL) + CW_BAR, MISC + 8);
#endif
    const int lo = args.ph_lo, hi = args.ph_hi;

    if (EN(10) && IN(0)) { if (REP(10)) { ph_prologue(PH_PASS); __syncthreads(); } ph_prologue(PH_PASS); }
    SEAM(0);
    if (EN(11) && IN(1)) ph_mod(PH_PASS);
    SEAM(1);
    layer_phases<0>(lo, hi, G, bx, vcu, NGW, lds, bar);
    if (NLAYER_LOOP > 1) layer_phases<1>(lo, hi, G, bx, vcu, NGW, lds, bar);
    if (EN(12) && IN(PH_FINAL)) { if (REP(12)) ph_final(PH_PASS); ph_final(PH_PASS); }
#undef IN
#undef SEAM
}


extern "C" void kernel_launch(void* const* d_in, const int* in_sizes, int n_in, void* d_out, int out_size, void* d_ws, size_t ws_size, hipStream_t stream) {
    static int grid = 0;
    if (grid == 0) {
        if (n_in != 24 || in_sizes[0] != MR * DM || out_size != MR * DM || ws_size < WS_END + SZ_X) { fprintf(stderr, "kernel_launch: unexpected problem (n_in %d, in0 %d, out %d, ws %zu < %zu); nothing launched\n", n_in, n_in > 0 ? in_sizes[0] : -1, out_size, ws_size, (size_t)WS_END); grid = -1; return; }
        int dev = 0, cus = 0, per_cu = 0;
        if (hipGetDevice(&dev) != hipSuccess || hipDeviceGetAttribute(&cus, hipDeviceAttributeMultiprocessorCount, dev) != hipSuccess) { grid = -1; return; }
        if (hipFuncSetAttribute((const void*)trunk_fwd, hipFuncAttributeMaxDynamicSharedMemorySize, LDS_BYTES) != hipSuccess) { fprintf(stderr, "kernel_launch: hipFuncSetAttribute failed\n"); grid = -1; return; }
        if (hipOccupancyMaxActiveBlocksPerMultiprocessor(&per_cu, (const void*)trunk_fwd, NWAVES * 64, LDS_BYTES) != hipSuccess || per_cu < 1) fprintf(stderr, "kernel_launch: occupancy query reports %d workgroups per CU\n", per_cu);
        (void)hipGetLastError();
        grid = cus;
    }
    if (grid < 0) return;
    if (hipMemsetAsync((char*)d_ws + WS_CTL, 0, CTL_ZERO_BYTES, stream) != hipSuccess) return;
    Args a{};
    for (int i = 0; i < 24; ++i) a.in[i] = (const float*)d_in[i];
    a.out = (float*)d_out; a.ws = (unsigned char*)d_ws;
#if MK_PER_PHASE
    for (int p = 0; p < PH_COUNT; ++p) { a.ph_lo = p; a.ph_hi = p + 1; hipLaunchKernelGGL(trunk_fwd, dim3(grid), dim3(NWAVES * 64), LDS_BYTES, stream, a); }
#else
    a.ph_lo = 0; a.ph_hi = PH_COUNT;
    hipLaunchKernelGGL(trunk_fwd, dim3(grid), dim3(NWAVES * 64), LDS_BYTES, stream, a);
#endif
}
```

```cpp
#include <hip/hip_runtime.h>
#include <cstdio>
#include <cstdint>

constexpr int DM = 4096, NBATCH = 2, SEQ = 4096, MR = NBATCH * SEQ, DEPTH = 2;
constexpr int SSMW = 2048, RETW = 2048, NG = 128, NP = 64, RH = 8, RD = 256, RC = 128, NCH = SEQ / RC;
constexpr int DFF = 16384, INW = 10240, MODW = 6 * DM;
constexpr float EPS = 1e-6f;

namespace pg8 {
#define PG8_LAS __attribute__((address_space(3)))
typedef unsigned short bf16_t;
typedef short bf16x8 __attribute__((ext_vector_type(8)));
typedef float f32x4 __attribute__((ext_vector_type(4)));
typedef unsigned u32x4 __attribute__((ext_vector_type(4)));
constexpr int BM = 256, BK = 64, HALF = 128, HTB = HALF * BK * 2  , STAGE_BYTES = 8 * HTB, NXCD = 8, WGM = 8;

__host__ __device__ __forceinline__ int lds_byte(int r, int c) { const int st = (r >> 4) * 2 + (c >> 5), rr = r & 15, cc = c & 31, ob = rr * 64 + cc * 2; return st * 1024 + (ob ^ (((ob >> 9) & 1) << 5)); }
__host__ __device__ __forceinline__ void stage_rc(int b, int& R, int& C) { const int st = b / 1024, sb = b % 1024, swz = sb ^ (((sb >> 9) & 1) << 5); R = (st >> 1) * 16 + swz / 64; C = (st & 1) * 32 + (swz % 64) / 2; }
__host__ __device__ __forceinline__ int perm32(int rho) { const int n = rho >> 4, i = rho & 15; return 8 * (i >> 2) + 4 * n + (i & 3); }

struct Unit { int pm, pn; };
struct Gemm { const bf16_t* A; const bf16_t* Bt; int M, N, K; };

struct StaticOrder {
    int nM, nN, nwg, G, c;
    __host__ __device__ void init(int M, int N, int G_, int c_) { nM = M / BM; nN = N / BM; nwg = nM * nN; G = G_; c = c_; }
    __host__ __device__ bool next(int i, Unit& u) const {
        const long L = (long)i * G + c; if (L >= nwg) return false;
        int wgid = (int)L; { const int q = nwg / NXCD, r = nwg % NXCD, xcd = wgid % NXCD, off = wgid / NXCD; wgid = (xcd < r ? xcd * (q + 1) : r * (q + 1) + (xcd - r) * q) + off; }
        const int nig = WGM * nN, gid = wgid / nig, fm = gid * WGM, gsz = (nM - fm) < WGM ? (nM - fm) : WGM;
        u.pm = fm + ((wgid % nig) % gsz); u.pn = (wgid % nig) / gsz; return true;
    }
    __device__ __forceinline__ void a_ready(const Unit&) const {}
    __device__ __forceinline__ void done(const Unit&) const {}
};

__device__ __forceinline__ unsigned cvt_pk_bf16(float lo, float hi) { unsigned r; asm volatile("v_cvt_pk_bf16_f32 %0, %1, %2" : "=v"(r) : "v"(lo), "v"(hi)); return r; }
typedef float f32x2 __attribute__((ext_vector_type(2)));

template <class Epi, class Sched, bool ALIGN_EPI = false, bool SP2 = false>
__device__ __forceinline__ void gemm_phase(PG8_LAS unsigned char* lds, const Gemm g, const Sched& S, const Epi& E) {
    int tid_ = threadIdx.x; asm volatile("" : "+v"(tid_));
    const int tid = tid_ & 511, wid = __builtin_amdgcn_readfirstlane(tid >> 6), lane = tid & 63, wr = wid >> 2, wc = wid & 3, fr = lane & 15, fq = lane >> 4;
    const int K = g.K, nt = K / BK;
    unsigned voffA[2], voffB[2];
#pragma unroll
    for (int i = 0; i < 2; ++i) { int R, C; stage_rc(tid * 16 + i * 8192, R, C); const int Rb = Epi::PERM ? ((R & ~31) + perm32(R & 31)) : R;
        voffA[i] = (unsigned)(R * K + C) * 2u; voffB[i] = (unsigned)(Rb * K + C) * 2u; }
    const size_t kstep = (size_t)(BK * 2);
    const size_t hstep = (size_t)HALF * K * 2;
    const size_t tstep = 2 * hstep;
    const unsigned ldsw = (unsigned)wid * 1024u;
    const int aoff = lds_byte(wr * 64 + fr, fq * 8), boff = lds_byte(wc * 32 + fr, fq * 8);
#define PG8_SA(b, h) (((b) * 2 + (h)) * HTB)
#define PG8_SB(b, h) ((4 + (b) * 2 + (h)) * HTB)
#define PG8_STAGE(bufoff, gbase, voff) do { _Pragma("unroll") for (int _i = 0; _i < 2; ++_i) \
        __builtin_amdgcn_global_load_lds((const unsigned*)((const char*)(gbase) + (voff)[_i]), (PG8_LAS unsigned*)(lds + (bufoff) + ldsw + _i * 8192), 16, 0, 0); } while (0)
#define PG8_LDA(dst, b, h) do { _Pragma("unroll") for (int m = 0; m < 4; ++m) _Pragma("unroll") for (int k = 0; k < 2; ++k) dst[m][k] = *(const PG8_LAS bf16x8*)(lds + PG8_SA(b, h) + aoff + m * 2048 + k * 1024); } while (0)
#define PG8_LDB(dst, b, h) do { _Pragma("unroll") for (int n = 0; n < 2; ++n) _Pragma("unroll") for (int k = 0; k < 2; ++k) dst[n][k] = *(const PG8_LAS bf16x8*)(lds + PG8_SB(b, h) + boff + n * 2048 + k * 1024); } while (0)
#define PG8_MMA(ai, bj, At, Bt) do { __builtin_amdgcn_s_setprio(1); _Pragma("unroll") for (int m = 0; m < 4; ++m) _Pragma("unroll") for (int n = 0; n < 2; ++n) _Pragma("unroll") for (int k = 0; k < 2; ++k) \
        acc[ai][bj][m][n] = __builtin_amdgcn_mfma_f32_16x16x32_bf16(Bt[n][k], At[m][k], acc[ai][bj][m][n], 0, 0, 0); __builtin_amdgcn_s_setprio(0); } while (0)
#define PG8_WAIT_V(n) asm volatile("s_waitcnt vmcnt(" #n ")" ::: "memory")
#define PG8_WAIT_L(n) asm volatile("s_waitcnt lgkmcnt(" #n ")" ::: "memory")
#define PG8_BAR __builtin_amdgcn_s_barrier()
#define PG8_SCHED __builtin_amdgcn_sched_barrier(0)
    Unit cur, nxt; int ui = 0;
    if (!S.next(0, cur)) return;
    f32x4 acc[2][2][4][2];
#pragma unroll
    for (int a = 0; a < 2; ++a)
#pragma unroll
        for (int b = 0; b < 2; ++b)
#pragma unroll
            for (int m = 0; m < 4; ++m)
#pragma unroll
                for (int n = 0; n < 2; ++n) acc[a][b][m][n] = (f32x4){0.f, 0.f, 0.f, 0.f};
    bf16x8 At[4][2], B0[2][2], B1[2][2];
    const char* cA = (const char*)g.A + (size_t)cur.pm * tstep; const char* cB = (const char*)g.Bt + (size_t)cur.pn * tstep;
    S.a_ready(cur);
    if constexpr (SP2) {
        PG8_STAGE(PG8_SB(0, 0), cB, voffB); PG8_STAGE(PG8_SB(0, 1), cB + hstep, voffB); PG8_STAGE(PG8_SA(0, 0), cA, voffA); PG8_STAGE(PG8_SA(0, 1), cA + hstep, voffA);
        if (wr == 1) PG8_BAR;
        PG8_WAIT_V(2); PG8_BAR;
        PG8_STAGE(PG8_SB(1, 0), cB + kstep, voffB); PG8_STAGE(PG8_SA(1, 0), cA + kstep, voffA); PG8_STAGE(PG8_SB(1, 1), cB + hstep + kstep, voffB);
        PG8_WAIT_V(6); PG8_BAR;
    } else {
        PG8_STAGE(PG8_SB(0, 0), cB, voffB); PG8_STAGE(PG8_SA(0, 0), cA, voffA); PG8_STAGE(PG8_SB(0, 1), cB + hstep, voffB); PG8_STAGE(PG8_SA(0, 1), cA + hstep, voffA);
        if (wr == 1) PG8_BAR;
        PG8_WAIT_V(4); PG8_BAR;
        PG8_STAGE(PG8_SB(1, 0), cB + kstep, voffB); PG8_STAGE(PG8_SA(1, 0), cA + kstep, voffA); PG8_STAGE(PG8_SB(1, 1), cB + hstep + kstep, voffB);
        PG8_WAIT_V(6); PG8_BAR;
    }
    for (;;) {
        const bool has_next = S.next(ui + 1, nxt);
        const char* nA = has_next ? (const char*)g.A + (size_t)nxt.pm * tstep : cA; const char* nB = has_next ? (const char*)g.Bt + (size_t)nxt.pn * tstep : cB;
        for (int t = 0; t < nt; t += 2) {
            if constexpr (Epi::HOOK) { if (t == (nt >> 1)) E.hook(acc, ui, wr, fr); }
            const bool last = (t == nt - 2);
            const char* a1 = cA + (size_t)(t + 1) * kstep;
            const char* a2 = last ? nA : cA + (size_t)(t + 2) * kstep; const char* b2 = last ? nB : cB + (size_t)(t + 2) * kstep;
            const char* a3 = a2 + kstep; const char* b3 = b2 + kstep;
            if (last && has_next) S.a_ready(nxt);
            if constexpr (SP2) {
            PG8_LDB(B0, 0, 0); PG8_LDB(B1, 0, 1); PG8_SCHED; PG8_LDA(At, 0, 0); PG8_STAGE(PG8_SA(1, 1), a1 + hstep, voffA);
            PG8_WAIT_V(8); PG8_WAIT_L(0); PG8_BAR; PG8_MMA(0, 0, At, B0); PG8_MMA(0, 1, At, B1); PG8_BAR; PG8_SCHED;
            PG8_LDA(At, 0, 1); PG8_STAGE(PG8_SB(0, 0), b2, voffB); PG8_STAGE(PG8_SB(0, 1), b2 + hstep, voffB); PG8_STAGE(PG8_SA(0, 0), a2, voffA);
            PG8_WAIT_V(8); PG8_WAIT_L(0); PG8_BAR; PG8_MMA(1, 0, At, B0); PG8_MMA(1, 1, At, B1); PG8_BAR; PG8_SCHED;
            PG8_LDB(B0, 1, 0); PG8_LDB(B1, 1, 1); PG8_SCHED; PG8_LDA(At, 1, 0); PG8_STAGE(PG8_SA(0, 1), a2 + hstep, voffA);
            PG8_WAIT_V(8); PG8_WAIT_L(0); PG8_BAR; PG8_MMA(0, 0, At, B0); PG8_MMA(0, 1, At, B1); PG8_BAR; PG8_SCHED;
            PG8_LDA(At, 1, 1); PG8_STAGE(PG8_SB(1, 0), b3, voffB); PG8_STAGE(PG8_SB(1, 1), b3 + hstep, voffB); PG8_STAGE(PG8_SA(1, 0), a3, voffA);
            PG8_WAIT_V(8); PG8_WAIT_L(0); PG8_BAR; PG8_MMA(1, 0, At, B0); PG8_MMA(1, 1, At, B1); PG8_BAR; PG8_SCHED;
            } else {
            PG8_LDB(B0, 0, 0); PG8_SCHED; PG8_LDA(At, 0, 0); PG8_STAGE(PG8_SA(1, 1), a1 + hstep, voffA);
            PG8_WAIT_L(8); PG8_BAR; PG8_WAIT_L(0); PG8_MMA(0, 0, At, B0); PG8_BAR; PG8_SCHED;
            PG8_LDB(B1, 0, 1); PG8_STAGE(PG8_SB(0, 0), b2, voffB);
            PG8_BAR; PG8_WAIT_L(0); PG8_MMA(0, 1, At, B1); PG8_BAR;
            PG8_LDA(At, 0, 1); PG8_STAGE(PG8_SA(0, 0), a2, voffA);
            PG8_BAR; PG8_WAIT_L(0); PG8_MMA(1, 0, At, B0); PG8_BAR; PG8_SCHED;
            PG8_STAGE(PG8_SB(0, 1), b2 + hstep, voffB);
            PG8_WAIT_V(6); PG8_BAR; PG8_MMA(1, 1, At, B1); PG8_BAR;
            PG8_LDB(B0, 1, 0); PG8_SCHED; PG8_LDA(At, 1, 0); PG8_STAGE(PG8_SA(0, 1), a2 + hstep, voffA);
            PG8_WAIT_L(8); PG8_BAR; PG8_WAIT_L(0); PG8_MMA(0, 0, At, B0); PG8_BAR; PG8_SCHED;
            PG8_LDB(B1, 1, 1); PG8_STAGE(PG8_SB(1, 0), b3, voffB);
            PG8_BAR; PG8_WAIT_L(0); PG8_MMA(0, 1, At, B1); PG8_BAR;
            PG8_LDA(At, 1, 1); PG8_STAGE(PG8_SA(1, 0), a3, voffA);
            PG8_BAR; PG8_WAIT_L(0); PG8_MMA(1, 0, At, B0); PG8_BAR; PG8_SCHED;
            PG8_STAGE(PG8_SB(1, 1), b3 + hstep, voffB);
            PG8_WAIT_V(6); PG8_BAR; PG8_MMA(1, 1, At, B1); PG8_BAR;
            }
        }
        if constexpr (ALIGN_EPI) { if (wr == 0) PG8_BAR; }
        if constexpr (!Epi::AFTER_DRAIN) { E(acc, cur, wr, wc, fr, fq); S.done(cur); }
        if (!has_next) break;
#pragma unroll
        for (int a = 0; a < 2; ++a)
#pragma unroll
            for (int b = 0; b < 2; ++b)
#pragma unroll
                for (int m = 0; m < 4; ++m)
#pragma unroll
                    for (int n = 0; n < 2; ++n) acc[a][b][m][n] = (f32x4){0.f, 0.f, 0.f, 0.f};
        cur = nxt; cA = nA; cB = nB; ++ui;
        if constexpr (ALIGN_EPI) { if (wr == 1) PG8_BAR; }
    }
    PG8_WAIT_V(0);
    if constexpr (!ALIGN_EPI) { if (wr == 0) PG8_BAR; }
    PG8_BAR;
    if constexpr (Epi::AFTER_DRAIN) { E.fused(acc, cur, wr, wc, fr, fq, lds, wid, lane); S.done(cur); }
#undef PG8_SA
#undef PG8_SB
#undef PG8_STAGE
#undef PG8_LDA
#undef PG8_LDB
#undef PG8_MMA
#undef PG8_WAIT_V
#undef PG8_WAIT_L
#undef PG8_BAR
#undef PG8_SCHED
}
}


namespace pg8 {
typedef unsigned u32x2 __attribute__((ext_vector_type(2)));
__device__ __forceinline__ float sigmoid_f(float z) { return __builtin_amdgcn_rcpf(1.0f + __builtin_amdgcn_exp2f(-1.4426950408889634f * z)); }
__device__ __forceinline__ float bf_lo(unsigned w) { return __uint_as_float(w << 16); }
__device__ __forceinline__ float bf_hi(unsigned w) { return __uint_as_float(w & 0xffff0000u); }

struct EpiIn {
    static constexpr bool PERM = true, AFTER_DRAIN = false, HOOK = false;
    bf16_t* proj; const float* rope; const float* kdec;
    __device__ __forceinline__ void operator()(const f32x4 (&acc)[2][2][4][2], const Unit& u, int wr, int wc, int fr, int fq) const {
        const int seg = u.pn >> 3, hb = u.pn & 7;
        bf16_t* base = proj + (size_t)seg * ((size_t)MR * 2048) + hb * 256 + wc * 32 + 8 * fq;
        const int row0 = u.pm * BM + wr * 64 + fr, pi0 = 16 * wc + 4 * fq;
        const bool rot = (seg == 1) || (seg == 2);
#pragma unroll
        for (int ai = 0; ai < 2; ++ai)
#pragma unroll
            for (int m = 0; m < 4; ++m) {
                const int row = row0 + ai * HALF + m * 16;
                bf16_t* rowp = base + (size_t)row * 2048;
                float ks = 1.f; if (seg == 2) ks = kdec[hb * 128 + (row & 127)];
#pragma unroll
                for (int bj = 0; bj < 2; ++bj) {
                    f32x4 v0 = acc[ai][bj][m][0], v1 = acc[ai][bj][m][1];
                    if (rot) {
                        const float* rp = rope + ((size_t)row * 128 + 64 * bj + pi0) * 2;
                        const f32x4 r0 = *(const f32x4*)rp, r1 = *(const f32x4*)(rp + 4);
                        f32x4 w0, w1;
                        w0[0] = v0[0] * r0[0] - v0[1] * r0[1]; w0[1] = v0[0] * r0[1] + v0[1] * r0[0];
                        w0[2] = v0[2] * r0[2] - v0[3] * r0[3]; w0[3] = v0[2] * r0[3] + v0[3] * r0[2];
                        w1[0] = v1[0] * r1[0] - v1[1] * r1[1]; w1[1] = v1[0] * r1[1] + v1[1] * r1[0];
                        w1[2] = v1[2] * r1[2] - v1[3] * r1[3]; w1[3] = v1[2] * r1[3] + v1[3] * r1[2];
                        v0 = w0 * ks; v1 = w1 * ks;
                    }
                    u32x4 w; w.x = cvt_pk_bf16(v0[0], v0[1]); w.y = cvt_pk_bf16(v0[2], v0[3]); w.z = cvt_pk_bf16(v1[0], v1[1]); w.w = cvt_pk_bf16(v1[2], v1[3]);
                    *(u32x4*)(rowp + bj * HALF) = w;
                }
            }
    }
};
struct EpiGlu {
    static constexpr bool PERM = true, AFTER_DRAIN = false, HOOK = false;
    const bf16_t* yg; bf16_t* mixed; const float* bglu; const float* gout; float* ssqp;
    __device__ __forceinline__ void operator()(const f32x4 (&acc)[2][2][4][2], const Unit& u, int wr, int wc, int fr, int fq) const {
        const int row0 = u.pm * BM + wr * 64 + fr, col0 = u.pn * BM + wc * 32 + 8 * fq;
        f32x4 bv[2][2], gv[2][2];
#pragma unroll
        for (int bj = 0; bj < 2; ++bj)
#pragma unroll
            for (int n = 0; n < 2; ++n) { bv[bj][n] = *(const f32x4*)(bglu + col0 + bj * HALF + 4 * n); gv[bj][n] = *(const f32x4*)(gout + col0 + bj * HALF + 4 * n); }
#pragma unroll
        for (int ai = 0; ai < 2; ++ai)
#pragma unroll
            for (int m = 0; m < 4; ++m) {
                const int row = row0 + ai * HALF + m * 16; float s = 0.f;
#pragma unroll
                for (int bj = 0; bj < 2; ++bj) {
                    const u32x4 yv = *(const u32x4*)(yg + (size_t)row * 2048 + col0 + bj * HALF);
                    const f32x4 z0 = acc[ai][bj][m][0] + bv[bj][0], z1 = acc[ai][bj][m][1] + bv[bj][1];
                    f32x4 o0, o1;
                    o0[0] = bf_lo(yv.x) * sigmoid_f(z0[0]); o0[1] = bf_hi(yv.x) * sigmoid_f(z0[1]); o0[2] = bf_lo(yv.y) * sigmoid_f(z0[2]); o0[3] = bf_hi(yv.y) * sigmoid_f(z0[3]);
                    o1[0] = bf_lo(yv.z) * sigmoid_f(z1[0]); o1[1] = bf_hi(yv.z) * sigmoid_f(z1[1]); o1[2] = bf_lo(yv.w) * sigmoid_f(z1[2]); o1[3] = bf_hi(yv.w) * sigmoid_f(z1[3]);
                    s += (o0[0] * o0[0] + o0[1] * o0[1]) + (o0[2] * o0[2] + o0[3] * o0[3]) + (o1[0] * o1[0] + o1[1] * o1[1]) + (o1[2] * o1[2] + o1[3] * o1[3]);
                    o0 = o0 * gv[bj][0]; o1 = o1 * gv[bj][1];
                    u32x4 w; w.x = cvt_pk_bf16(o0[0], o0[1]); w.y = cvt_pk_bf16(o0[2], o0[3]); w.z = cvt_pk_bf16(o1[0], o1[1]); w.w = cvt_pk_bf16(o1[2], o1[3]);
                    *(u32x4*)(mixed + (size_t)row * 4096 + col0 + bj * HALF) = w;
                }
                s += __shfl_xor(s, 16); s += __shfl_xor(s, 32);
                if (fq == 0) ssqp[(size_t)row * 32 + u.pn * 4 + wc] = s;
            }
    }
};
template <bool HK> struct EpiRes {
    static constexpr bool PERM = false, AFTER_DRAIN = false, HOOK = HK;
    const float* xin; float* xout; const float* gate; const PG8_LAS float* rs;
    __device__ __forceinline__ void hook(f32x4 (&acc)[2][2][4][2], int ui, int wr, int fr) const {
#pragma unroll
        for (int ai = 0; ai < 2; ++ai)
#pragma unroll
            for (int m = 0; m < 4; ++m) { const float s = rs[(ui & 1) * 256 + ai * HALF + wr * 64 + m * 16 + fr];
#pragma unroll
                for (int bj = 0; bj < 2; ++bj)
#pragma unroll
                    for (int n = 0; n < 2; ++n) acc[ai][bj][m][n] = acc[ai][bj][m][n] * s; }
    }
    __device__ __forceinline__ void operator()(const f32x4 (&acc)[2][2][4][2], const Unit& u, int wr, int wc, int fr, int fq) const {
        const int row0 = u.pm * BM + wr * 64 + fr, col0 = u.pn * BM + wc * 32 + 4 * fq;
        const float* gp = gate + (size_t)(u.pm >> 4) * MODW + col0;
        f32x4 gv[2][2];
#pragma unroll
        for (int bj = 0; bj < 2; ++bj)
#pragma unroll
            for (int n = 0; n < 2; ++n) gv[bj][n] = *(const f32x4*)(gp + bj * HALF + n * 16);
#pragma unroll
        for (int ai = 0; ai < 2; ++ai)
#pragma unroll
            for (int m = 0; m < 4; ++m) { const size_t off = (size_t)(row0 + ai * HALF + m * 16) * DM + col0;
#pragma unroll
                for (int bj = 0; bj < 2; ++bj)
#pragma unroll
                    for (int n = 0; n < 2; ++n) { const f32x4 xi = *(const f32x4*)(xin + off + bj * HALF + n * 16);
                        *(f32x4*)(xout + off + bj * HALF + n * 16) = xi + gv[bj][n] * acc[ai][bj][m][n]; }
                asm volatile("" ::: "memory"); }
    }
};
struct EpiUp {
    static constexpr bool PERM = true, AFTER_DRAIN = false, HOOK = false;
    bf16_t* hid;
    __device__ __forceinline__ void operator()(const f32x4 (&acc)[2][2][4][2], const Unit& u, int wr, int wc, int fr, int fq) const {
        const int row0 = u.pm * BM + wr * 64 + fr, col0 = u.pn * BM + wc * 32 + 8 * fq;
#pragma unroll
        for (int ai = 0; ai < 2; ++ai)
#pragma unroll
            for (int m = 0; m < 4; ++m) { bf16_t* rowp = hid + (size_t)(row0 + ai * HALF + m * 16) * DFF + col0;
#pragma unroll
                for (int bj = 0; bj < 2; ++bj) { f32x4 v0 = acc[ai][bj][m][0], v1 = acc[ai][bj][m][1];
#pragma unroll
                    for (int j = 0; j < 4; ++j) { const float a = fmaxf(v0[j], 0.f), b = fmaxf(v1[j], 0.f); v0[j] = a * a; v1[j] = b * b; }
                    u32x4 w; w.x = cvt_pk_bf16(v0[0], v0[1]); w.y = cvt_pk_bf16(v0[2], v0[3]); w.z = cvt_pk_bf16(v1[0], v1[1]); w.w = cvt_pk_bf16(v1[2], v1[3]);
                    *(u32x4*)(rowp + bj * HALF) = w; } }
    }
};
}

constexpr int NWAVES = 8;
#ifndef MK_PER_PHASE
#define MK_PER_PHASE 0
#endif
constexpr size_t AL(size_t x) { return (x + 4095) & ~(size_t)4095; }
constexpr size_t WS_CTL = 0, CTL_ZERO_BYTES = 1u << 20;
constexpr size_t SZ_WIN = (size_t)INW * DM * 2, SZ_WGLU = (size_t)SSMW * SSMW * 2, SZ_WOUT = (size_t)DM * DM * 2, SZ_WUP = (size_t)DFF * DM * 2, SZ_WDOWN = SZ_WUP;
constexpr size_t WS_WIN = CTL_ZERO_BYTES, WS_WGLU = WS_WIN + 2 * SZ_WIN, WS_WOUT = WS_WGLU + 2 * SZ_WGLU, WS_WUP = WS_WOUT + 2 * SZ_WOUT, WS_WDOWN = WS_WUP + 2 * SZ_WUP;
constexpr size_t WS_ADAP = WS_WDOWN + 2 * SZ_WDOWN, SZ_ADAP = (size_t)DEPTH * 64 * NBATCH * MODW * 4;
constexpr size_t WS_MOD = WS_ADAP + SZ_ADAP, SZ_MOD = AL((size_t)DEPTH * NBATCH * MODW * 4);
constexpr size_t WS_ROPE = WS_MOD + SZ_MOD, SZ_ROPE = (size_t)MR * 128 * 8;
constexpr size_t WS_LAMB = WS_ROPE + SZ_ROPE, SZ_LAMB = AL((size_t)DEPTH * NG * NP * 8);
constexpr size_t WS_LAMT = WS_LAMB + SZ_LAMB;
constexpr size_t WS_BCAT = WS_LAMT + SZ_LAMB, SZ_BCAT = AL((size_t)DEPTH * NG * 128 * 16 * 2);
constexpr size_t WS_CCAT = WS_BCAT + SZ_BCAT;
constexpr size_t WS_DEC = WS_CCAT + SZ_BCAT, SZ_DEC = 16384;
constexpr size_t WS_HBUF = WS_DEC + SZ_DEC, SZ_HBUF = (size_t)MR * DM * 2;
constexpr size_t WS_PROJ = WS_HBUF + SZ_HBUF, SZ_PROJ1 = (size_t)MR * 2048 * 2;
constexpr size_t WS_YG = WS_PROJ + 5 * SZ_PROJ1;
constexpr size_t WS_MIXED = WS_YG + SZ_PROJ1;
constexpr size_t WS_SSQP = WS_MIXED + SZ_HBUF, SZ_SSQP = (size_t)MR * 32 * 4;
constexpr size_t WS_X = WS_SSQP + SZ_SSQP, SZ_X = (size_t)MR * DM * 4;
constexpr size_t WS_HID = WS_X + SZ_X, SZ_HID = (size_t)MR * DFF * 2;
constexpr size_t WS_KV = WS_HID + SZ_HID, SZ_KV = (size_t)NBATCH * RH * NCH * RD * RD * 4;
constexpr size_t WS_ST = WS_KV + SZ_KV, SZ_ST = SZ_KV / 2;
constexpr size_t WS_S5E = WS_ST + SZ_ST, SZ_S5E = (size_t)NBATCH * NG * NCH * 128 * 4;
constexpr size_t WS_S5C = WS_S5E + SZ_S5E;
constexpr size_t WS_END = WS_S5C + SZ_S5E;
constexpr int CW_BAR = 4096;
constexpr int RING_BYTES = 139264;
constexpr int RS_OFF = 131072;
constexpr int LDSCTL_OFF = RING_BYTES, MISC_OFF = LDSCTL_OFF + 320;
constexpr int LDS_BYTES = 147456;
static_assert(MISC_OFF + 128 <= LDS_BYTES, "LDS map");

#define GAS __attribute__((address_space(1)))
#define LAS __attribute__((address_space(3)))
typedef unsigned short bf16;
typedef unsigned v4u __attribute__((ext_vector_type(4)));
typedef unsigned v2u __attribute__((ext_vector_type(2)));
typedef float f32x4 __attribute__((ext_vector_type(4)));
typedef float f32x2 __attribute__((ext_vector_type(2)));
typedef float f32x16 __attribute__((ext_vector_type(16)));
typedef short bf16x8 __attribute__((ext_vector_type(8)));
typedef short s16x4 __attribute__((ext_vector_type(4)));
typedef short v4i16_t __attribute__((ext_vector_type(4)));
typedef GAS unsigned gu32;
#define RLX_AGENT __ATOMIC_RELAXED, __HIP_MEMORY_SCOPE_AGENT
#define LDS_WAIT() asm volatile("s_waitcnt lgkmcnt(0)" ::: "memory")
#define VM_WAIT() asm volatile("s_waitcnt vmcnt(0)" ::: "memory")
__device__ __forceinline__ unsigned f2bf(float f) { unsigned u = __builtin_bit_cast(unsigned, f); return (u + 0x7fffu + ((u >> 16) & 1u)) >> 16; }
__device__ __forceinline__ unsigned pk2(float lo, float hi) { return pg8::cvt_pk_bf16(lo, hi); }
__device__ __forceinline__ float bflo(unsigned w) { return __uint_as_float(w << 16); }
__device__ __forceinline__ float bfhi(unsigned w) { return __uint_as_float(w & 0xffff0000u); }
__device__ __forceinline__ s16x4 vtr(const LAS unsigned char* p) { return __builtin_bit_cast(s16x4, __builtin_amdgcn_ds_read_tr16_b64_v4i16((LAS v4i16_t*)p)); }
__device__ __forceinline__ bf16x8 cat8(s16x4 a, s16x4 b) { bf16x8 r; r[0] = a[0]; r[1] = a[1]; r[2] = a[2]; r[3] = a[3]; r[4] = b[0]; r[5] = b[1]; r[6] = b[2]; r[7] = b[3]; return r; }
__device__ __forceinline__ float wave_sum(float v) {
#pragma unroll
    for (int o = 1; o < 64; o <<= 1) v += __shfl_xor(v, o);
    return v;
}
#define MFMA16(a, b, c) __builtin_amdgcn_mfma_f32_16x16x32_bf16((a), (b), (c), 0, 0, 0)
#define MFMA32(a, b, c) __builtin_amdgcn_mfma_f32_32x32x16_bf16((a), (b), (c), 0, 0, 0)


#define XB_TMO      128
#define XB_XCNT(j)  (256  + 64 * (j))
#define XB_XSUB(j)  (1280 + 64 * (j))
#define XB_XGEN(j)  (2304 + 64 * (j))
#define XB_TOP      3328
#define XB_TOPGEN   3392
#define XCD_BAR_WORDS 3456
#define XB_SPIN_CAP (1u << 18)

__device__ __forceinline__ unsigned xb_ld(unsigned* p)              { return __hip_atomic_load(p, __ATOMIC_RELAXED, __HIP_MEMORY_SCOPE_AGENT); }
__device__ __forceinline__ unsigned xb_add(unsigned* p, unsigned v) { return __hip_atomic_fetch_add(p, v, __ATOMIC_RELAXED, __HIP_MEMORY_SCOPE_AGENT); }
__device__ __forceinline__ unsigned xb_xcc_id() { return (unsigned)__builtin_amdgcn_s_getreg((3 << 11) | 20) & 0xFu; }
#define XB_SPIN(cond, bar) do { unsigned _sp = 0; while (cond) { __builtin_amdgcn_s_sleep(1); \
    if ((++_sp & 255u) == 0u) { if (xb_ld(&(bar)[XB_TMO])) break; if (_sp > XB_SPIN_CAP) { atomicAdd(&(bar)[XB_TMO], 1u); break; } } } } while (0)

struct XcdBarrier {
    unsigned* bar; unsigned x;
    volatile LAS unsigned* st;
};

__device__ __forceinline__ XcdBarrier xcd_barrier_post(unsigned* bar, volatile LAS unsigned* st) {
    XcdBarrier b; b.bar = bar; b.x = xb_xcc_id(); b.st = st;
    if (threadIdx.x == 0) (void)xb_add(&bar[XB_XCNT(b.x)], 1u);
    return b;
}
__device__ __forceinline__ void xcd_barrier_complete(unsigned* bar, unsigned x, unsigned& nloc, unsigned& nx) {
    const unsigned G = gridDim.x * gridDim.y * gridDim.z;
    unsigned sum, cnt, mine, sp = 0u;
    for (;;) {
        sum = 0u; cnt = 0u; mine = 0u;
#pragma unroll
        for (unsigned j = 0; j < 16; ++j) { const unsigned c = xb_ld(&bar[XB_XCNT(j)]); sum += c; cnt += (c > 0u) ? 1u : 0u; mine = (j == x) ? c : mine; }
        if (sum == G) break;
        __builtin_amdgcn_s_sleep(1);
        if ((++sp & 255u) == 0u) { if (xb_ld(&bar[XB_TMO])) break; if (sp > XB_SPIN_CAP) { atomicAdd(&bar[XB_TMO], 1u); break; } }
    }
    nloc = mine > 0u ? mine : 1u; nx = cnt > 0u ? cnt : 1u;
}

__device__ __forceinline__ void xcd_barrier(const XcdBarrier& b) {
    asm volatile("s_waitcnt vmcnt(0)" ::: "memory");
    __syncthreads();
    if (threadIdx.x == 0) {
        unsigned* bar = b.bar;
        __builtin_amdgcn_s_waitcnt(0);
        unsigned nloc = b.st[0], nx = b.st[1];
        if (nloc == 0u) { xcd_barrier_complete(bar, b.x, nloc, nx); b.st[0] = nloc; b.st[1] = nx; }
        const unsigned old = xb_add(&bar[XB_XSUB(b.x)], 1u);
        const unsigned gen = old / nloc;
        if (old + 1u == (gen + 1u) * nloc) {
            __builtin_amdgcn_fence(__ATOMIC_RELEASE, "agent");
            asm volatile("s_waitcnt vmcnt(0)" ::: "memory");
            const unsigned og = xb_add(&bar[XB_TOP], 1u);
            const unsigned tg = og / nx;
            if (og + 1u == (tg + 1u) * nx) xb_add(&bar[XB_TOPGEN], 1u);
            else XB_SPIN(xb_ld(&bar[XB_TOPGEN]) == tg, bar);
            __builtin_amdgcn_fence(__ATOMIC_ACQUIRE, "agent");
            xb_add(&bar[XB_XGEN(b.x)], 1u);
            asm volatile("s_waitcnt vmcnt(0)" ::: "memory");
        } else {
            XB_SPIN(xb_ld(&bar[XB_XGEN(b.x)]) == gen, bar);
            __builtin_amdgcn_fence(__ATOMIC_ACQUIRE, "agent");
            asm volatile("s_waitcnt vmcnt(0)" ::: "memory");
        }
    }
    __syncthreads();
}

#define CAS __attribute__((address_space(4)))
__device__ __forceinline__ const void* karg_ptr(int byte_off) {
    int o = byte_off; asm volatile("" : "+s"(o));
    const CAS char* kp = (const CAS char*)__builtin_amdgcn_kernarg_segment_ptr();
    return *(const void* const CAS*)(kp + o);
}
#define INP(i) ((const float*)karg_ptr(8 * (i)))
#define WSP() ((unsigned char*)karg_ptr(8 * 25))
#define OUTP() ((float*)karg_ptr(8 * 24))
__device__ __forceinline__ void sincos_d(double x, double& s, double& c) {
    const double q = rint(x * 0.63661977236758134308);
    double r = fma(-q, 1.57079632679489655800e+00, x); r = fma(-q, 6.12323399573676603587e-17, r);
    const int k = (int)((long long)q & 3);
    const double r2 = r * r;
    const double sp = r * (1.0 + r2 * (-1.0 / 6.0 + r2 * (1.0 / 120.0 + r2 * (-1.0 / 5040.0 + r2 * (1.0 / 362880.0 + r2 * (-1.0 / 39916800.0 + r2 * (1.0 / 6227020800.0)))))));
    const double cp = 1.0 + r2 * (-0.5 + r2 * (1.0 / 24.0 + r2 * (-1.0 / 720.0 + r2 * (1.0 / 40320.0 + r2 * (-1.0 / 3628800.0 + r2 * (1.0 / 479001600.0 + r2 * (-1.0 / 87178291200.0)))))));
    s = (k == 0) ? sp : (k == 1) ? cp : (k == 2) ? -sp : -cp;
    c = (k == 0) ? cp : (k == 1) ? -sp : (k == 2) ? -cp : sp;
}
__device__ __forceinline__ int permqk(int n) {
    if (n < 2048 || n >= 6144) return n;
    const int r = n - 2048, i = r & 255;
    return 2048 + (r & ~255) + 2 * (i & 127) + (i >> 7);
}
__device__ __forceinline__ void tr_tile_load(const float* W, int N, int k0, int n0, int lane, f32x4 (&v)[16]) {
    const int l5 = lane & 31, hf = lane >> 5, lr = l5 >> 3, lc = (l5 & 7) + 8 * hf;
    const float* wp = W + (size_t)(k0 + lr) * N + n0 + 4 * lc;
#pragma unroll
    for (int i = 0; i < 16; ++i) v[i] = __builtin_nontemporal_load((const f32x4*)(wp + (size_t)(4 * i) * N));
}
__device__ __forceinline__ void tr_tile_store(const f32x4 (&v)[16], bf16* WT, int K, int k0, int n0, bool pq, LAS float* scr, int lane) {
    const int l5 = lane & 31, hf = lane >> 5, lr = l5 >> 3, lc = (l5 & 7) + 8 * hf;
    LAS float* sw = scr + lr * 65 + 4 * lc;
#pragma unroll
    for (int i = 0; i < 16; ++i) { sw[(4 * i) * 65 + 0] = v[i].x; sw[(4 * i) * 65 + 1] = v[i].y; sw[(4 * i) * 65 + 2] = v[i].z; sw[(4 * i) * 65 + 3] = v[i].w; }
    LDS_WAIT(); asm volatile("" ::: "memory");
    const int nn = l5 >> 2, kc = (l5 & 3) + 4 * hf;
#pragma unroll
    for (int j = 0; j < 8; ++j) { const int n = nn + 8 * j; const LAS float* s = scr + (8 * kc) * 65 + n;
        v4u o; o.x = pk2(s[0 * 65], s[1 * 65]); o.y = pk2(s[2 * 65], s[3 * 65]); o.z = pk2(s[4 * 65], s[5 * 65]); o.w = pk2(s[6 * 65], s[7 * 65]);
        const int orow = pq ? permqk(n0 + n) : (n0 + n);
        *(GAS v4u*)(WT + (size_t)orow * K + k0 + 8 * kc) = o; }
    LDS_WAIT(); asm volatile("" ::: "memory");
}
template <bool PQK>
__device__ __forceinline__ void p0_transpose_item(const float* W, int K, int N, bf16* WT, LAS float* scr, int item, int lane) {
    const int nblk = N / 64, kb = item / nblk, nb = item % nblk, k0 = 64 * kb, n0 = 64 * nb;
    f32x4 v[16]; tr_tile_load(W, N, k0, n0, lane, v); tr_tile_store(v, WT, K, k0, n0, PQK, scr, lane);
}
__device__ __forceinline__ void p0_ada_item(const float* c, const float* w_ada, float* adap, int item, int lane) {
    const int l = item / 6144, r = item % 6144, ks = r / 96, nc = r % 96;
    const float c0 = c[64 * ks + lane], c1 = c[DM + 64 * ks + lane];
    const float a0 = c0 * pg8::sigmoid_f(c0), a1 = c1 * pg8::sigmoid_f(c1);
    const float* wp = w_ada + ((size_t)l * DM + 64 * ks) * MODW + 256 * nc + 4 * lane;
    f32x4 s0 = {0.f, 0.f, 0.f, 0.f}, s1 = {0.f, 0.f, 0.f, 0.f};
#pragma unroll 16
    for (int k = 0; k < 64; ++k) {
        const f32x4 w = __builtin_nontemporal_load((const f32x4*)(wp + (size_t)k * MODW));
        const float b0 = __builtin_bit_cast(float, __builtin_amdgcn_readlane(__builtin_bit_cast(int, a0), k));
        const float b1 = __builtin_bit_cast(float, __builtin_amdgcn_readlane(__builtin_bit_cast(int, a1), k));
        s0 = s0 + w * b0; s1 = s1 + w * b1;
    }
    float* op = adap + (((size_t)l * 64 + ks) * 2) * MODW + 256 * nc + 4 * lane;
    *(f32x4*)op = s0; *(f32x4*)(op + MODW) = s1;
}
__device__ __forceinline__ void p0_rope_item(const int* positions, float* rope, int m, int lane) {
    const float pos = (float)positions[m];
#pragma unroll
    for (int t = 0; t < 2; ++t) { const int i = lane + 64 * t;
        const float inv = (float)exp2(-(double)i * (13.287712379549449 / 128.0));
        const float ang = pos * inv;
        double s, c; sincos_d((double)ang, s, c);
        *(f32x2*)(rope + ((size_t)m * 128 + i) * 2) = (f32x2){(float)c, (float)s}; }
}
__device__ __forceinline__ void p0_dec_item(float* dec, int lane) {
#pragma unroll
    for (int h = 0; h < 8; ++h) { const double lg = log2(1.0 - exp2(-5.0 - (double)h));
#pragma unroll
        for (int t = 0; t < 2; ++t) { const int j = lane + 64 * t;
            dec[h * 128 + j] = (float)(exp2((double)(127 - j) * lg) * 0.0625);
            dec[1024 + h * 128 + j] = (float)exp2((double)(j - 127) * lg); }
        if (lane == 0) dec[2048 + h] = (float)exp2(128.0 * lg); }
}
struct S5In { const float *lam_re, *lam_im, *log_dt, *b_re, *b_im, *c_re, *c_im; };
__device__ __forceinline__ void p0_s5_item(const S5In& P, f32x2* lamb, f32x2* lamt, bf16* bcat, bf16* ccat, int item, int lane) {
    const int lg = item, p = lane;
    const double lr = P.lam_re[lg * 64 + p], li = P.lam_im[lg * 64 + p], dt = exp((double)P.log_dt[lg]);
    double s, c; sincos_d(li * dt, s, c); const double er = exp(lr * dt), lbr = er * c, lbi = er * s;
    double s2, c2; sincos_d(128.0 * li * dt, s2, c2); const double e2 = exp(128.0 * lr * dt);
    lamb[lg * 64 + p] = (f32x2){(float)lbr, (float)lbi}; lamt[lg * 64 + p] = (f32x2){(float)(e2 * c2), (float)(e2 * s2)};
    const double nr = lbr - 1.0, ni = lbi, den = lr * lr + li * li, cr = (nr * lr + ni * li) / den, ci = (ni * lr - nr * li) / den;
    const float* br = P.b_re + ((size_t)lg * 64 + p) * 16; const float* bi = P.b_im + ((size_t)lg * 64 + p) * 16;
    bf16* o_re = bcat + ((size_t)lg * 128 + p) * 16; bf16* o_im = bcat + ((size_t)lg * 128 + 64 + p) * 16;
#pragma unroll
    for (int h = 0; h < 16; ++h) { const double xr = br[h], xi = bi[h]; o_re[h] = (bf16)f2bf((float)(cr * xr - ci * xi)); o_im[h] = (bf16)f2bf((float)(cr * xi + ci * xr)); }
#pragma unroll
    for (int h = 0; h < 16; ++h) { ccat[((size_t)lg * 16 + h) * 128 + p] = (bf16)f2bf(P.c_re[((size_t)lg * 16 + h) * 64 + p]); ccat[((size_t)lg * 16 + h) * 128 + 64 + p] = (bf16)f2bf(-P.c_im[((size_t)lg * 16 + h) * 64 + p]); }
}

__device__ __forceinline__ void norm_rows_bf16(const float* x, bf16* out, const float* g, const float* shift, const float* scale, int gw, int NGW, int lane) {
    for (int m = gw; m < MR; m += NGW) {
        const f32x4* xr = (const f32x4*)(x + (size_t)m * DM) + lane; const int b = m >> 12;
        f32x4 v[16]; float ss = 0.f;
#pragma unroll
        for (int j = 0; j < 16; ++j) { v[j] = xr[64 * j]; ss += (v[j].x * v[j].x + v[j].y * v[j].y) + (v[j].z * v[j].z + v[j].w * v[j].w); }
        const float rstd = 1.0f / sqrtf(wave_sum(ss) * (1.0f / DM) + EPS);
        const f32x4* gp = (const f32x4*)g + lane; const f32x4* sh = (const f32x4*)(shift + (size_t)b * MODW) + lane; const f32x4* sc = (const f32x4*)(scale + (size_t)b * MODW) + lane;
        v2u* op = (v2u*)(out + (size_t)m * DM) + lane;
#pragma unroll
        for (int j = 0; j < 16; ++j) { const f32x4 o = v[j] * rstd * gp[64 * j] * (1.0f + sc[64 * j]) + sh[64 * j]; v2u w; w.x = pk2(o.x, o.y); w.y = pk2(o.z, o.w); op[64 * j] = w; }
    }
}
__device__ __forceinline__ void norm_rows_f32(const float* x, float* out, const float* g, int gw, int NGW, int lane) {
    for (int m = gw; m < MR; m += NGW) {
        const f32x4* xr = (const f32x4*)(x + (size_t)m * DM) + lane;
        f32x4 v[16]; float ss = 0.f;
#pragma unroll
        for (int j = 0; j < 16; ++j) { v[j] = xr[64 * j]; ss += (v[j].x * v[j].x + v[j].y * v[j].y) + (v[j].z * v[j].z + v[j].w * v[j].w); }
        const float rstd = 1.0f / sqrtf(wave_sum(ss) * (1.0f / DM) + EPS);
        const f32x4* gp = (const f32x4*)g + lane; f32x4* op = (f32x4*)(out + (size_t)m * DM) + lane;
#pragma unroll
        for (int j = 0; j < 16; ++j) op[64 * j] = v[j] * rstd * gp[64 * j];
    }
}

__device__ __forceinline__ float gelu_tanh(float x) { const float z = 0.7978845608028654f * (x + 0.044715f * x * x * x); return x * __builtin_amdgcn_rcpf(1.0f + __builtin_amdgcn_exp2f(-2.8853900817779268f * z)); }
#define S5_SCAN(RE, IM, LR, LI, SR, SI) do { _Pragma("unroll") for (int r_ = 0; r_ < 16; ++r_) { \
        const float nr_ = fmaf(LR, SR, fmaf(-(LI), SI, RE[r_])), ni_ = fmaf(LR, SI, fmaf(LI, SR, IM[r_])); SR = nr_; SI = ni_; RE[r_] = nr_; IM[r_] = ni_; } } while (0)
#define S5_FIX(RE, IM, LR, LI, CR, CI) do { _Pragma("unroll") for (int r_ = 0; r_ < 16; ++r_) { \
        const float nr_ = LR * CR - LI * CI, ni_ = LR * CI + LI * CR; CR = nr_; CI = ni_; RE[r_] += nr_; IM[r_] += ni_; } } while (0)
struct RiderNone { static constexpr bool ON = false;
    __device__ __forceinline__ bool load(int, f32x4 (&)[16]) const { return false; }
    __device__ __forceinline__ void store(int, const f32x4 (&)[16], LAS float*) const {} };
constexpr int TT_IN = (DM / 64) * (INW / 64), TT_GLU = (SSMW / 64) * (SSMW / 64), TT_OUT = (DM / 64) * (DM / 64), TT_UP = (DM / 64) * (DFF / 64), TT_DOWN = (DFF / 64) * (DM / 64);
constexpr int RIDE_S1 = 3, RIDE_S3 = 10, RIDE_TILES = (RIDE_S1 + RIDE_S3) * 2048;
template <int SEQ> __device__ __forceinline__ bool seq_decode(int r, const float*& W, bf16*& WT, int& K, int& N, int& k0, int& n0, bool& pq) {
    constexpr int TOTAL = SEQ == 0 ? TT_IN + TT_GLU + TT_OUT + TT_UP + TT_DOWN : TT_UP + TT_DOWN;
    pq = false; if (r >= TOTAL) return false;
    unsigned char* ws = WSP();
    if (SEQ == 0) {
        if (r < TT_IN) { W = INP(6) + (size_t)DM * INW; WT = (bf16*)(ws + WS_WIN) + (size_t)INW * DM; K = DM; N = INW; k0 = 64 * (r / (INW / 64)); n0 = 64 * (r % (INW / 64)); pq = true; return true; } r -= TT_IN;
        if (r < TT_GLU) { W = INP(15) + (size_t)SSMW * SSMW; WT = (bf16*)(ws + WS_WGLU) + (size_t)SSMW * SSMW; K = SSMW; N = SSMW; k0 = 64 * (r / (SSMW / 64)); n0 = 64 * (r % (SSMW / 64)); return true; } r -= TT_GLU;
        if (r < TT_OUT) { W = INP(19) + (size_t)DM * DM; WT = (bf16*)(ws + WS_WOUT) + (size_t)DM * DM; K = DM; N = DM; k0 = 64 * (r / (DM / 64)); n0 = 64 * (r % (DM / 64)); return true; } r -= TT_OUT;
    }
    constexpr int L = SEQ;
    if (r < TT_UP) { W = INP(21) + (size_t)L * DM * DFF; WT = (bf16*)(ws + WS_WUP) + (size_t)L * DFF * DM; K = DM; N = DFF; k0 = 64 * (r / (DFF / 64)); n0 = 64 * (r % (DFF / 64)); return true; } r -= TT_UP;
    W = INP(22) + (size_t)L * DFF * DM; WT = (bf16*)(ws + WS_WDOWN) + (size_t)L * DM * DFF; K = DFF; N = DM; k0 = 64 * (r / (DM / 64)); n0 = 64 * (r % (DM / 64)); return true;
}
template <int SEQ> struct RiderConv { static constexpr bool ON = true;
    int gw, NGW, lane, base, quota;
    __device__ __forceinline__ bool load(int slot, f32x4 (&v)[16]) const {
        const float* W; bf16* WT; int K, N, k0, n0; bool pq; if (slot >= quota || !seq_decode<SEQ>(gw + NGW * (base + slot), W, WT, K, N, k0, n0, pq)) return false;
        tr_tile_load(W, N, k0, n0, lane, v); return true; }
    __device__ __forceinline__ void store(int slot, const f32x4 (&v)[16], LAS float* scr) const {
        const float* W; bf16* WT; int K, N, k0, n0; bool pq; if (!seq_decode<SEQ>(gw + NGW * (base + slot), W, WT, K, N, k0, n0, pq)) return;
        tr_tile_store(v, WT, K, k0, n0, pq, scr, lane); }
    __device__ __forceinline__ void finish(int done, LAS float* scr) const { for (int sl = done; sl < quota; ++sl) { f32x4 tv[16]; if (load(sl, tv)) store(sl, tv, scr); } }
};
__device__ __forceinline__ float bcast_lo(float x) { const unsigned u = __float_as_uint(x); auto t = __builtin_amdgcn_permlane32_swap(u, u, false, false); return __uint_as_float(t[0]); }
__device__ __forceinline__ float bcast_hi(float x) { const unsigned u = __float_as_uint(x); auto t = __builtin_amdgcn_permlane32_swap(u, u, false, false); return __uint_as_float(t[1]); }
template <int PASS, class Rider = RiderNone>
__device__ __forceinline__ void s5_unit(const bf16* U, const f32x2* lamb, const bf16* bcat, const bf16* ccat, const float* dskip, float* s5e, const float* s5c, bf16* yg,
                                        int layer, int b, int g, int c, LAS unsigned char* wl, int lane, const Rider& RD = Rider(), int slot0 = 0) {
    const int r32 = lane & 31, hh = lane >> 5, g4 = lane >> 4, i16 = lane & 15, q4 = i16 >> 2, p4 = lane & 3;
    const int lg = layer * NG + g;
    const f32x2 la0 = lamb[lg * 64 + r32], la1 = lamb[lg * 64 + 32 + r32];
    const float l0r = la0.x, l0i = la0.y, l1r = la1.x, l1i = la1.y;
    bf16x8 bfr[4];
#pragma unroll
    for (int nb = 0; nb < 4; ++nb) bfr[nb] = *(const bf16x8*)(bcat + ((size_t)lg * 128 + 32 * nb + r32) * 16 + 8 * hh);
    float x0r = 0.f, x0i = 0.f, x1r = 0.f, x1i = 0.f;
    const size_t sidx = (((size_t)b * NG + g) * NCH + c) * 128;
    float m0r = 1.f, m0i = 0.f, m1r = 1.f, m1i = 0.f;
    bf16x8 cfr[4];
    if (PASS == 3) { x0r = s5c[sidx + r32]; x0i = s5c[sidx + 64 + r32]; x1r = s5c[sidx + 32 + r32]; x1i = s5c[sidx + 96 + r32];
#pragma unroll
        for (int ks = 0; ks < 4; ++ks) cfr[ks] = *(const bf16x8*)(ccat + ((size_t)lg * 16 + i16) * 128 + 32 * ks + 8 * g4);
    } else { m0r = l0r; m0i = l0i; m1r = l1r; m1i = l1i;
#pragma unroll
        for (int k = 0; k < 4; ++k) { const float a = m0r * m0r - m0i * m0i, bb = 2.f * m0r * m0i; m0r = a; m0i = bb; const float a1 = m1r * m1r - m1i * m1i, b1 = 2.f * m1r * m1i; m1r = a1; m1i = b1; } }
    const int tokperm = 16 * ((r32 >> 2) & 1) + (r32 & 3) + 4 * (r32 >> 3);
    const size_t row0 = (size_t)b * SEQ + (size_t)c * RC;
    const f32x16 z16 = {0.f, 0.f, 0.f, 0.f, 0.f, 0.f, 0.f, 0.f, 0.f, 0.f, 0.f, 0.f, 0.f, 0.f, 0.f, 0.f};
    const bf16* ua = U + (row0 + tokperm) * 2048 + g * 16 + 8 * hh;
    const bf16* ue = U + (row0 + i16) * 2048 + g * 16 + 4 * g4;
    f32x4 dk = {0.f, 0.f, 0.f, 0.f}; if (PASS == 3) dk = *(const f32x4*)(dskip + layer * SSMW + g * 16 + 4 * g4);
    bf16x8 a_nxt = *(const bf16x8*)ua;
#pragma unroll
    for (int blk = 0; blk < 4; ++blk) {
        const bf16x8 a = a_nxt;
        if (blk < 3) a_nxt = *(const bf16x8*)(ua + (size_t)(blk + 1) * 32 * 2048);
        f32x4 tv[16]; bool tvalid = false;
        if constexpr (Rider::ON) { tvalid = RD.load(slot0 + blk, tv); __builtin_amdgcn_sched_barrier(0); }
        v2u uv0 = {0u, 0u}, uv1 = {0u, 0u};
        if (PASS == 3) { uv0 = *(const v2u*)(ue + (size_t)(32 * blk) * 2048); uv1 = *(const v2u*)(ue + (size_t)(32 * blk + 16) * 2048); }
        f32x16 d0 = MFMA32(a, bfr[0], z16), d1 = MFMA32(a, bfr[1], z16), d2 = MFMA32(a, bfr[2], z16), d3 = MFMA32(a, bfr[3], z16);
        float s0r = hh ? 0.f : x0r, s0i = hh ? 0.f : x0i, s1r = hh ? 0.f : x1r, s1i = hh ? 0.f : x1i;
        S5_SCAN(d0, d2, l0r, l0i, s0r, s0i);
        S5_SCAN(d1, d3, l1r, l1i, s1r, s1i);
        float c0r = bcast_lo(s0r), c0i = bcast_lo(s0i), c1r = bcast_lo(s1r), c1i = bcast_lo(s1i);
        if (PASS == 1) {
            const float e0r = m0r * c0r - m0i * c0i + s0r, e0i = m0r * c0i + m0i * c0r + s0i, e1r = m1r * c1r - m1i * c1i + s1r, e1i = m1r * c1i + m1i * c1r + s1i;
            x0r = bcast_hi(e0r); x0i = bcast_hi(e0i); x1r = bcast_hi(e1r); x1i = bcast_hi(e1i);
        } else {
            c0r = hh ? c0r : 0.f; c0i = hh ? c0i : 0.f; c1r = hh ? c1r : 0.f; c1i = hh ? c1i : 0.f;
            S5_FIX(d0, d2, l0r, l0i, c0r, c0i);
            S5_FIX(d1, d3, l1r, l1i, c1r, c1i);
            x0r = bcast_hi(d0[15]); x0i = bcast_hi(d2[15]); x1r = bcast_hi(d1[15]); x1i = bcast_hi(d3[15]);
            {
                v4u w;
                LAS unsigned char* base = wl + 32 * hh;
#define S5_PUT(D, ROW) do { LAS unsigned char* p_ = base + (ROW) * 96; \
                w.x = pk2(D[0], D[1]); w.y = pk2(D[2], D[3]); w.z = pk2(D[4], D[5]); w.w = pk2(D[6], D[7]); *(LAS v4u*)p_ = w; \
                w.x = pk2(D[8], D[9]); w.y = pk2(D[10], D[11]); w.z = pk2(D[12], D[13]); w.w = pk2(D[14], D[15]); *(LAS v4u*)(p_ + 16) = w; } while (0)
                S5_PUT(d0, r32); S5_PUT(d1, 32 + r32); S5_PUT(d2, 64 + r32); S5_PUT(d3, 96 + r32);
#undef S5_PUT
            }
            LDS_WAIT();
#pragma unroll
            for (int tb = 0; tb < 2; ++tb) {
                f32x4 y = {0.f, 0.f, 0.f, 0.f};
#pragma unroll
                for (int ks = 0; ks < 4; ++ks) {
                    const LAS unsigned char* ap = wl + (32 * ks + 8 * g4 + q4) * 96 + 32 * tb + 8 * p4;
                    const s16x4 t0 = vtr(ap), t1 = vtr(ap + 4 * 96);
                    y = MFMA16(cfr[ks], cat8(t0, t1), y);
                }
                const size_t off = (row0 + 32 * blk + 16 * tb + i16) * 2048 + g * 16 + 4 * g4;
                const v2u uv = tb ? uv1 : uv0;
                const float y0 = gelu_tanh(y[0] + dk[0] * bflo(uv.x)), y1 = gelu_tanh(y[1] + dk[1] * bfhi(uv.x)), y2 = gelu_tanh(y[2] + dk[2] * bflo(uv.y)), y3 = gelu_tanh(y[3] + dk[3] * bfhi(uv.y));
                v2u o; o.x = pk2(y0, y1); o.y = pk2(y2, y3);
                *(v2u*)(yg + off) = o;
            }
            LDS_WAIT();
        }
        if constexpr (Rider::ON) { if (tvalid) RD.store(slot0 + blk, tv, (LAS float*)wl); }
    }
    if (PASS == 1 && hh == 0) { s5e[sidx + r32] = x0r; s5e[sidx + 64 + r32] = x0i; s5e[sidx + 32 + r32] = x1r; s5e[sidx + 96 + r32] = x1i; }
}
__device__ __forceinline__ void s5_carry(const f32x2* lamt, const float* s5e, float* s5c, int layer, int bg, int lane) {
    const int g = bg & (NG - 1); const f32x2 lt = lamt[(layer * NG + g) * 64 + lane];
    const size_t base = (size_t)bg * NCH * 128;
    float er[NCH], ei[NCH];
#pragma unroll
    for (int c = 0; c < NCH; ++c) { er[c] = s5e[base + c * 128 + lane]; ei[c] = s5e[base + c * 128 + 64 + lane]; }
    float xr = 0.f, xi = 0.f;
#pragma unroll
    for (int c = 0; c < NCH; ++c) { s5c[base + c * 128 + lane] = xr; s5c[base + c * 128 + 64 + lane] = xi;
        const float nr = lt.x * xr - lt.y * xi + er[c], ni = lt.x * xi + lt.y * xr + ei[c]; xr = nr; xi = ni; }
}

constexpr int RSTR = 544;
__device__ __forceinline__ void ret_stage(const bf16* src, size_t row0, int h, LAS unsigned char* img, int tid) {
#pragma unroll
    for (int i = 0; i < 8; ++i) { const int idx = tid + 512 * i, row = idx >> 5, ch = idx & 31;
        const v4u v = *(const v4u*)(src + (row0 + row) * 2048 + h * 256 + ch * 8); *(LAS v4u*)(img + row * RSTR + ch * 16) = v; }
}
__device__ __forceinline__ void ret_kv_unit(const bf16* Kp, const bf16* Vp, bf16* kv, int unit, LAS unsigned char* lds, int tid, int wave, int lane) {
    const int bh = unit >> 5, c = unit & 31, b = bh >> 3, h = bh & 7;
    const size_t row0 = (size_t)b * SEQ + (size_t)c * RC;
    LAS unsigned char* kimg = lds; LAS unsigned char* vimg = lds + 128 * RSTR;
    ret_stage(Kp, row0, h, kimg, tid); ret_stage(Vp, row0, h, vimg, tid);
    __syncthreads();
    const int r32 = lane & 31, hh = lane >> 5, blk = (lane >> 4) & 1, q4 = (lane & 15) >> 2, p4 = lane & 3;
    const int lo = (8 * hh + q4) * RSTR + 32 * blk + 8 * p4;
    bf16x8 af[8];
#pragma unroll
    for (int ks = 0; ks < 8; ++ks) { const LAS unsigned char* ap = vimg + lo + (16 * ks) * RSTR + 64 * wave; af[ks] = cat8(vtr(ap), vtr(ap + 4 * RSTR)); }
    bf16* op = kv + (size_t)unit * 65536 + (size_t)wave * 8192 + r32 * 8 + 4 * hh;
#pragma unroll
    for (int dt = 0; dt < 8; ++dt) {
        f32x16 acc = {0.f, 0.f, 0.f, 0.f, 0.f, 0.f, 0.f, 0.f, 0.f, 0.f, 0.f, 0.f, 0.f, 0.f, 0.f, 0.f};
#pragma unroll
        for (int ks = 0; ks < 8; ++ks) { const LAS unsigned char* bp = kimg + lo + (16 * ks) * RSTR + 64 * dt; acc = MFMA32(cat8(vtr(bp), vtr(bp + 4 * RSTR)), af[ks], acc); }
#pragma unroll
        for (int q = 0; q < 4; ++q) { v2u w;
            w.x = f2bf(acc[4 * q]) | (f2bf(acc[4 * q + 1]) << 16); w.y = f2bf(acc[4 * q + 2]) | (f2bf(acc[4 * q + 3]) << 16);
            *(v2u*)(op + ((2 * dt + (q >> 1)) * 64 + (q & 1) * 32) * 8) = w; }
    }
    __syncthreads();
}
__device__ __forceinline__ void ret_scan_item(const bf16* kv, bf16* st, const float* dec, int item) {
    const int bh = item >> 14, e4 = item & 16383, h = bh & 7; const float g128 = dec[2048 + h];
    const v2u* kp = (const v2u*)(kv + (size_t)bh * NCH * 65536) + e4; v2u* sp = (v2u*)(st + (size_t)bh * NCH * 65536) + e4;
    f32x4 s = {0.f, 0.f, 0.f, 0.f};
#pragma unroll 8
    for (int c = 0; c < NCH; ++c) { const v2u kw = kp[(size_t)c * 16384]; const f32x4 k = {bflo(kw.x), bfhi(kw.x), bflo(kw.y), bfhi(kw.y)};
        v2u w; w.x = pk2(s.x, s.y); w.y = pk2(s.z, s.w); sp[(size_t)c * 16384] = w; s = (s + k) * g128; }
}
constexpr int QSTR = 528, PSTR = 272, R3_P = 69632, R3_RED = 104448;
__device__ __forceinline__ void ret_out_unit(const bf16* Qp, const bf16* Kp, const bf16* Vp, const bf16* Gp, const bf16* st, const float* dec, const float* gnorm, bf16* mixed,
                                             int unit, LAS unsigned char* lds, int tid, int wave, int lane) {
    const int bh = unit >> 5, c = unit & 31, b = bh >> 3, h = bh & 7;
    const size_t row0 = (size_t)b * SEQ + (size_t)c * RC;
    const int r32 = lane & 31, hh = lane >> 5, i16 = lane & 15, g4 = lane >> 4, blk = g4 & 1, q4 = i16 >> 2, p4 = lane & 3;
    bf16x8 sfr[16];
    { const bf16* sp = st + (size_t)unit * 65536 + (size_t)wave * 8192 + lane * 8;
#pragma unroll
      for (int ks = 0; ks < 16; ++ks) sfr[ks] = *(const bf16x8*)(sp + 512 * ks); }
#pragma unroll
    for (int i = 0; i < 8; ++i) { const int idx = tid + 512 * i, row = idx >> 5, ch = idx & 31;
        const v4u v = *(const v4u*)(Qp + (row0 + row) * 2048 + h * 256 + ch * 8); *(LAS v4u*)(lds + row * QSTR + ch * 16) = v; }
    __syncthreads();
    {
        bf16x8 qa[8];
        { const LAS unsigned char* qp = lds + (16 * wave + i16) * QSTR + 16 * g4;
#pragma unroll
          for (int ks = 0; ks < 8; ++ks) qa[ks] = *(const LAS bf16x8*)(qp + 64 * ks); }
        const bf16* kp = Kp + (row0 + i16) * 2048 + h * 256 + 8 * g4;
        LAS unsigned char* pw = lds + R3_P + (16 * wave + 4 * g4) * PSTR + 2 * i16;
#define R3_LD8(D, P) do { _Pragma("unroll") for (int ks_ = 0; ks_ < 8; ++ks_) D[ks_] = *(const bf16x8*)((P) + 32 * ks_); } while (0)
        bf16x8 ka[8], kb[8];
        R3_LD8(ka, kp);
#pragma unroll
        for (int mt = 0; mt < 8; ++mt) {
            if (mt > wave) break;
            f32x4 s = {0.f, 0.f, 0.f, 0.f};
            constexpr int dummy_ = 0; (void)dummy_;
            const int nx = (mt + 1 < 8) ? mt + 1 : 7;
            if (mt & 1) { R3_LD8(ka, kp + (size_t)nx * 16 * 2048);
                __builtin_amdgcn_sched_barrier(0);
#pragma unroll
                for (int ks = 0; ks < 8; ++ks) s = MFMA16(qa[ks], kb[ks], s); }
            else { R3_LD8(kb, kp + (size_t)nx * 16 * 2048);
                __builtin_amdgcn_sched_barrier(0);
#pragma unroll
                for (int ks = 0; ks < 8; ++ks) s = MFMA16(qa[ks], ka[ks], s); }
            if (mt == wave) {
#pragma unroll
                for (int r = 0; r < 4; ++r) if (i16 > 4 * g4 + r) s[r] = 0.f;
            }
#pragma unroll
            for (int r = 0; r < 4; ++r) *(LAS bf16*)(pw + r * PSTR + 32 * mt) = (bf16)f2bf(s[r]);
        }
        if (!(wave & 1)) {
#pragma unroll
            for (int r = 0; r < 4; ++r) *(LAS bf16*)(pw + r * PSTR + 32 * (wave + 1)) = (bf16)0;
        }
#undef R3_LD8
    }
    v4u vreg[8];
#pragma unroll
    for (int i = 0; i < 8; ++i) { const int idx = tid + 512 * i, row = idx >> 5, ch = idx & 31; vreg[i] = *(const v4u*)(Vp + (row0 + row) * 2048 + h * 256 + ch * 8); }
    __syncthreads();
    f32x16 acc[4];
#pragma unroll
    for (int nb = 0; nb < 4; ++nb) acc[nb] = (f32x16){0.f, 0.f, 0.f, 0.f, 0.f, 0.f, 0.f, 0.f, 0.f, 0.f, 0.f, 0.f, 0.f, 0.f, 0.f, 0.f};
    { const LAS unsigned char* qb = lds + r32 * QSTR + 16 * hh;
#pragma unroll
      for (int ks = 0; ks < 16; ++ks) {
#pragma unroll
          for (int nb = 0; nb < 4; ++nb) acc[nb] = MFMA32(sfr[ks], *(const LAS bf16x8*)(qb + nb * 32 * QSTR + 32 * ks), acc[nb]);
      } }
    __syncthreads();
#pragma unroll
    for (int i = 0; i < 8; ++i) { const int idx = tid + 512 * i, row = idx >> 5, ch = idx & 31; *(LAS v4u*)(lds + row * RSTR + ch * 16) = vreg[i]; }
    __syncthreads();
    {
        bf16x8 af[8];
        const int lo = (8 * hh + q4) * RSTR + 32 * blk + 8 * p4;
#pragma unroll
        for (int ks = 0; ks < 8; ++ks) { const LAS unsigned char* ap = lds + lo + (16 * ks) * RSTR + 64 * wave; af[ks] = cat8(vtr(ap), vtr(ap + 4 * RSTR)); }
        const LAS unsigned char* pb = lds + R3_P + r32 * PSTR + 16 * hh;
#pragma unroll
        for (int nb = 0; nb < 4; ++nb) {
#pragma unroll
            for (int ks = 0; ks < 8; ++ks) if (ks <= 2 * nb + 1) acc[nb] = MFMA32(af[ks], *(const LAS bf16x8*)(pb + nb * 32 * PSTR + 32 * ks), acc[nb]);
        }
    }
    const int e0 = 32 * wave + 4 * hh;
    f32x4 nv[4];
#pragma unroll
    for (int qd = 0; qd < 4; ++qd) nv[qd] = *(const f32x4*)(gnorm + h * 256 + e0 + 8 * qd);
    v4u greg[8];
    { const bf16* gp = Gp + (row0 + (lane >> 2)) * 2048 + h * 256 + 32 * wave + 8 * (lane & 3);
#pragma unroll
      for (int i = 0; i < 8; ++i) greg[i] = *(const v4u*)(gp + (size_t)(16 * i) * 2048); }
    LAS unsigned char* gw = lds + wave * 10240;
    LAS float* red = (LAS float*)(lds + R3_RED);
    float mu[4], rs[4];
#pragma unroll
    for (int nb = 0; nb < 4; ++nb) { const float sc = dec[1024 + h * 128 + 32 * nb + r32]; float s = 0.f;
#pragma unroll
        for (int r = 0; r < 16; ++r) { acc[nb][r] *= sc; s += acc[nb][r]; }
        s += __shfl_xor(s, 32);
        if (hh == 0) red[wave * 128 + 32 * nb + r32] = s; }
    __syncthreads();
#pragma unroll
    for (int i = 0; i < 8; ++i) *(LAS v4u*)(gw + (16 * i + (lane >> 2)) * 80 + (lane & 3) * 16) = greg[i];
#pragma unroll
    for (int nb = 0; nb < 4; ++nb) { float s = 0.f;
#pragma unroll
        for (int w = 0; w < 8; ++w) s += red[w * 128 + 32 * nb + r32];
        mu[nb] = s * (1.0f / 256.0f); float q = 0.f;
#pragma unroll
        for (int r = 0; r < 16; ++r) { acc[nb][r] -= mu[nb]; q += acc[nb][r] * acc[nb][r]; }
        q += __shfl_xor(q, 32);
        if (hh == 0) red[1024 + wave * 128 + 32 * nb + r32] = q; }
    __syncthreads();
#pragma unroll
    for (int nb = 0; nb < 4; ++nb) { float q = 0.f;
#pragma unroll
        for (int w = 0; w < 8; ++w) q += red[1024 + w * 128 + 32 * nb + r32];
        rs[nb] = 1.0f / sqrtf(q * (1.0f / 256.0f) + EPS); }
#pragma unroll
    for (int nb = 0; nb < 4; ++nb) {
        LAS unsigned char* pq = gw + (32 * nb + r32) * 80 + 8 * hh;
#pragma unroll
        for (int qd = 0; qd < 4; ++qd) {
            const v2u gv = *(const LAS v2u*)(pq + 16 * qd);
            const float g0 = bflo(gv.x), g1 = bfhi(gv.x), g2 = bflo(gv.y), g3 = bfhi(gv.y);
            const float o0 = acc[nb][4 * qd + 0] * rs[nb] * nv[qd][0] * (g0 * pg8::sigmoid_f(g0)), o1 = acc[nb][4 * qd + 1] * rs[nb] * nv[qd][1] * (g1 * pg8::sigmoid_f(g1));
            const float o2 = acc[nb][4 * qd + 2] * rs[nb] * nv[qd][2] * (g2 * pg8::sigmoid_f(g2)), o3 = acc[nb][4 * qd + 3] * rs[nb] * nv[qd][3] * (g3 * pg8::sigmoid_f(g3));
            v2u w; w.x = pk2(o0, o1); w.y = pk2(o2, o3); *(LAS v2u*)(pq + 16 * qd) = w;
        }
    }
    LDS_WAIT();
    { bf16* op = mixed + (row0 + (lane >> 2)) * 4096 + 2048 + h * 256 + 32 * wave + 8 * (lane & 3);
#pragma unroll
      for (int i = 0; i < 8; ++i) { const v4u o = *(const LAS v4u*)(gw + (16 * i + (lane >> 2)) * 80 + (lane & 3) * 16); *(v4u*)(op + (size_t)(16 * i) * 4096) = o; } }
    __syncthreads();
}

struct Args { const float* in[24]; float* out; unsigned char* ws; int ph_lo, ph_hi; };
#ifndef NLAYER_LOOP
#define NLAYER_LOOP DEPTH
#endif
constexpr int PH_LAYER0 = 2, PH_PER_LAYER = 10, PH_FINAL = PH_LAYER0 + DEPTH * PH_PER_LAYER, PH_COUNT = PH_FINAL + 1;

#if MK_PER_PHASE
#define GRID_BAR() do { } while (0)
#else
#define GRID_BAR() xcd_barrier(bar)
#endif
#ifndef PHMASK
#define PHMASK 0x1fff
#endif
#define EN(j) (((PHMASK) >> (j)) & 1)
#define IN(k) (lo <= (k) && (k) < hi)
#define SEAM(k) do { if (IN(k) && IN((k) + 1)) GRID_BAR(); } while (0)
#define PHASE_IDS() int tid_ = threadIdx.x; asm volatile("" : "+v"(tid_)); const int tid = tid_ & 511, lane = tid & 63, wave = __builtin_amdgcn_readfirstlane(tid >> 6); \
    const int gw = vcu * NWAVES + wave  , gwT = wave * G + vcu  ; (void)gw; (void)gwT; (void)lane; (void)tid
#define PH_ARGS const int G, const int bx, const int vcu, const int NGW, LAS unsigned char* lds
#define PH_PASS G, bx, vcu, NGW, lds
constexpr size_t WS_DUMMY = WS_END;
template <int layer, int SUB> __device__ __forceinline__ void ph_norm(PH_ARGS) {
    PHASE_IDS(); unsigned char* ws = WSP(); const float* modl = (const float*)(ws + WS_MOD) + (size_t)layer * NBATCH * MODW;
    const float* xcur = (layer == 0 && SUB == 0) ? INP(0) : (const float*)(ws + WS_X);
    norm_rows_bf16(xcur, (bf16*)(ws + WS_HBUF), INP(SUB == 0 ? 5 : 20) + (size_t)layer * DM, modl + (3 * SUB) * DM, modl + (3 * SUB + 1) * DM, gw, NGW, lane);
}
template <int layer> __device__ __forceinline__ void ph_gemm_in(PH_ARGS) {
    PHASE_IDS(); unsigned char* ws = WSP();
    pg8::Gemm g{(const bf16*)(ws + WS_HBUF), (const bf16*)(ws + WS_WIN) + (size_t)layer * INW * DM, MR, INW, DM}; pg8::StaticOrder S; S.init(MR, INW, G, bx);
    pg8::EpiIn E{(bf16*)(ws + WS_PROJ), (const float*)(ws + WS_ROPE), (const float*)(ws + WS_DEC)};
    pg8::gemm_phase<pg8::EpiIn, pg8::StaticOrder, true, true>(lds, g, S, E);
}
template <int layer> __device__ __forceinline__ void ph_local(PH_ARGS) {
    PHASE_IDS(); unsigned char* ws = WSP(); const bf16* proj = (const bf16*)(ws + WS_PROJ);
    { RiderConv<layer> RD; RD.gw = gw; RD.NGW = 2048; RD.lane = lane; RD.base = 0; RD.quota = (G == 256) ? RIDE_S1 : 0; int slot = 0;
      for (int k = vcu; k < 1024; k += G, slot += 4) { const int b = k >> 9, rem = k & 511, c = rem >> 4, g = (rem & 15) * 8 + wave;
          s5_unit<1, RiderConv<layer>>(proj, (const f32x2*)(ws + WS_LAMB), (const bf16*)(ws + WS_BCAT), (const bf16*)(ws + WS_CCAT), nullptr, (float*)(ws + WS_S5E), nullptr, nullptr, layer, b, g, c, lds + wave * 16640, lane, RD, slot); }
      RD.finish(slot, (LAS float*)(lds + wave * 16640));
      if (G != 256) for (int t = gw; t < RIDE_TILES; t += NGW) {
          const float* W; bf16* WT; int K, N, k0, n0; bool pq; f32x4 tv[16];
          if (seq_decode<layer>(t, W, WT, K, N, k0, n0, pq)) { tr_tile_load(W, N, k0, n0, lane, tv); tr_tile_store(tv, WT, K, k0, n0, pq, (LAS float*)(lds + wave * 16640), lane); } } }
    __syncthreads();
    for (int u = vcu; u < NBATCH * RH * NCH; u += G) ret_kv_unit(proj + (size_t)2 * MR * 2048, proj + (size_t)3 * MR * 2048, (bf16*)(ws + WS_KV), u, lds, tid, wave, lane);
}
template <int layer> __device__ __forceinline__ void ph_carry(PH_ARGS) {
    PHASE_IDS(); unsigned char* ws = WSP();
    for (int bg = gwT; bg < NBATCH * NG; bg += NGW) s5_carry((const f32x2*)(ws + WS_LAMT), (const float*)(ws + WS_S5E), (float*)(ws + WS_S5C), layer, bg, lane);
    for (int it = gw * 64 + lane; it < NBATCH * RH * 16384; it += NGW * 64) ret_scan_item((const bf16*)(ws + WS_KV), (bf16*)(ws + WS_ST), (const float*)(ws + WS_DEC), it);
}
template <int layer, int MODE = 0> __device__ __forceinline__ void ph_outputs(PH_ARGS) {
    PHASE_IDS(); unsigned char* ws = WSP(); const bf16* proj = (const bf16*)(ws + WS_PROJ);
    if (MODE != 2) { const float* dsk = INP(14);
      RiderConv<layer> RD; RD.gw = gw; RD.NGW = 2048; RD.lane = lane; RD.base = RIDE_S1; RD.quota = (G == 256) ? RIDE_S3 : 0; int slot = 0;
      for (int k = vcu; k < 1024; k += G, slot += 4) { const int b = k >> 9, rem = k & 511, c = rem >> 4, g = (rem & 15) * 8 + wave;
          s5_unit<3, RiderConv<layer>>(proj, (const f32x2*)(ws + WS_LAMB), (const bf16*)(ws + WS_BCAT), (const bf16*)(ws + WS_CCAT), dsk, nullptr, (const float*)(ws + WS_S5C), (bf16*)(ws + WS_YG), layer, b, g, c, lds + wave * 16640, lane, RD, slot); }
      RD.finish(slot, (LAS float*)(lds + wave * 16640)); }
    __syncthreads();
    if (MODE != 1) { const float* gn = INP(18) + (size_t)layer * RETW;
      for (int u = vcu; u < NBATCH * RH * NCH; u += G)
        ret_out_unit(proj + (size_t)1 * MR * 2048, proj + (size_t)2 * MR * 2048, proj + (size_t)3 * MR * 2048, proj + (size_t)4 * MR * 2048, (const bf16*)(ws + WS_ST), (const float*)(ws + WS_DEC), gn, (bf16*)(ws + WS_MIXED), u, lds, tid, wave, lane); }
}
template <int layer> __device__ __forceinline__ void ph_glu(PH_ARGS) {
    PHASE_IDS(); unsigned char* ws = WSP();
    pg8::Gemm g{(const bf16*)(ws + WS_YG), (const bf16*)(ws + WS_WGLU) + (size_t)layer * SSMW * SSMW, MR, SSMW, SSMW}; pg8::StaticOrder S; S.init(MR, SSMW, G, bx);
    pg8::EpiGlu E{(const bf16*)(ws + WS_YG), (bf16*)(ws + WS_MIXED), INP(16) + (size_t)layer * SSMW, INP(17) + (size_t)layer * SSMW, (float*)(ws + WS_SSQP)};
    pg8::gemm_phase<pg8::EpiGlu, pg8::StaticOrder, true, true>(lds, g, S, E);
}
template <int layer, bool DUMMY> __device__ __forceinline__ void ph_out(PH_ARGS) {
    PHASE_IDS(); unsigned char* ws = WSP();
    pg8::Gemm g{(const bf16*)(ws + WS_MIXED), (const bf16*)(ws + WS_WOUT) + (size_t)layer * DM * DM, MR, DM, DM}; pg8::StaticOrder S; S.init(MR, DM, G, bx);
    { pg8::Unit u; const int ui = tid >> 8; LAS float* rs = (LAS float*)(lds + RS_OFF); const float* ssqp = (const float*)(ws + WS_SSQP);
      if (S.next(ui, u)) { const f32x4* pp = (const f32x4*)(ssqp + (size_t)(u.pm * 256 + (tid & 255)) * 32); f32x4 s = pp[0];
#pragma unroll
          for (int j = 1; j < 8; ++j) s = s + pp[j];
          rs[tid] = 1.0f / sqrtf(((s.x + s.y) + (s.z + s.w)) * (1.0f / SSMW) + EPS); }
      __syncthreads(); }
    const float* xcur = (layer == 0) ? INP(0) : (const float*)(ws + WS_X);
    pg8::EpiRes<true> E{xcur, (float*)(ws + (DUMMY ? WS_DUMMY : WS_X)), (const float*)(ws + WS_MOD) + (size_t)layer * NBATCH * MODW + 2 * DM, (const LAS float*)(lds + RS_OFF)};
    pg8::gemm_phase<pg8::EpiRes<true>, pg8::StaticOrder, true, true>(lds, g, S, E);
}
template <int layer> __device__ __forceinline__ void ph_up(PH_ARGS) {
    PHASE_IDS(); unsigned char* ws = WSP();
    pg8::Gemm g{(const bf16*)(ws + WS_HBUF), (const bf16*)(ws + WS_WUP) + (size_t)layer * DFF * DM, MR, DFF, DM}; pg8::StaticOrder S; S.init(MR, DFF, G, bx);
    pg8::EpiUp E{(bf16*)(ws + WS_HID)};
    pg8::gemm_phase<pg8::EpiUp, pg8::StaticOrder, true, true>(lds, g, S, E);
}
template <int layer, bool DUMMY> __device__ __forceinline__ void ph_down(PH_ARGS) {
    PHASE_IDS(); unsigned char* ws = WSP();
    pg8::Gemm g{(const bf16*)(ws + WS_HID), (const bf16*)(ws + WS_WDOWN) + (size_t)layer * DM * DFF, MR, DM, DFF}; pg8::StaticOrder S; S.init(MR, DM, G, bx);
    pg8::EpiRes<false> E{(const float*)(ws + WS_X), (float*)(ws + (DUMMY ? WS_DUMMY : WS_X)), (const float*)(ws + WS_MOD) + (size_t)layer * NBATCH * MODW + 5 * DM, (const LAS float*)(lds + RS_OFF)};
    pg8::gemm_phase<pg8::EpiRes<false>, pg8::StaticOrder, true, true>(lds, g, S, E);
}
__device__ __forceinline__ void ph_prologue(PH_ARGS) {
    PHASE_IDS(); unsigned char* ws = WSP();
    LAS float* scr = (LAS float*)(lds + wave * 16640);
    constexpr int N_ADA = DEPTH * 64 * 96;
    constexpr int T_IN = TT_IN, T_GLU = TT_GLU, T_OUT = TT_OUT;
    constexpr int N_L0 = T_IN + T_GLU + T_OUT;
    constexpr int N_SQ0 = TT_IN + TT_GLU + TT_OUT + TT_UP + TT_DOWN - RIDE_TILES, N_SQ1 = TT_UP + TT_DOWN - RIDE_TILES;
    constexpr int N_TR = N_L0 + N_SQ0 + N_SQ1, N_ROPE = MR, N_S5 = DEPTH * NG, N_ITEMS = N_ADA + N_TR + N_ROPE + N_S5 + 1;
    for (int it = gw; it < N_ITEMS; it += NGW) {
        int r = it;
        if (r < N_ADA) { p0_ada_item(INP(1), INP(3), (float*)(ws + WS_ADAP), r, lane); continue; } r -= N_ADA;
        if (r < N_TR) {
            if (r < T_IN) { p0_transpose_item<true>(INP(6), DM, INW, (bf16*)(ws + WS_WIN), scr, r, lane); continue; } r -= T_IN;
            if (r < T_GLU) { p0_transpose_item<false>(INP(15), SSMW, SSMW, (bf16*)(ws + WS_WGLU), scr, r, lane); continue; } r -= T_GLU;
            if (r < T_OUT) { p0_transpose_item<false>(INP(19), DM, DM, (bf16*)(ws + WS_WOUT), scr, r, lane); continue; } r -= T_OUT;
            const float* W; bf16* WT; int K, N, k0, n0; bool pq; f32x4 tv[16];
            if (r < N_SQ0) { if (seq_decode<0>(RIDE_TILES + r, W, WT, K, N, k0, n0, pq)) { tr_tile_load(W, N, k0, n0, lane, tv); tr_tile_store(tv, WT, K, k0, n0, pq, scr, lane); } continue; } r -= N_SQ0;
            if (seq_decode<1>(RIDE_TILES + r, W, WT, K, N, k0, n0, pq)) { tr_tile_load(W, N, k0, n0, lane, tv); tr_tile_store(tv, WT, K, k0, n0, pq, scr, lane); } continue;
        } r -= N_TR;
        if (r < N_ROPE) { p0_rope_item((const int*)INP(2), (float*)(ws + WS_ROPE), r, lane); continue; } r -= N_ROPE;
        if (r < N_S5) { S5In sp; sp.lam_re = INP(7); sp.lam_im = INP(8); sp.log_dt = INP(9); sp.b_re = INP(10); sp.b_im = INP(11); sp.c_re = INP(12); sp.c_im = INP(13);
            p0_s5_item(sp, (f32x2*)(ws + WS_LAMB), (f32x2*)(ws + WS_LAMT), (bf16*)(ws + WS_BCAT), (bf16*)(ws + WS_CCAT), r, lane); continue; }
        p0_dec_item((float*)(ws + WS_DEC), lane);
    }
}
__device__ __forceinline__ void ph_mod(PH_ARGS) {
    PHASE_IDS(); unsigned char* ws = WSP(); const float* b_ada = INP(4); const float* adap = (const float*)(ws + WS_ADAP); float* mod = (float*)(ws + WS_MOD);
    for (int i = gw * 64 + lane; i < DEPTH * NBATCH * (MODW / 4); i += NGW * 64) {
        const int l = i / (NBATCH * (MODW / 4)), r = i % (NBATCH * (MODW / 4)), b = r / (MODW / 4), n4 = r % (MODW / 4);
        f32x4 s = *((const f32x4*)(b_ada + (size_t)l * MODW) + n4);
        const f32x4* pp = (const f32x4*)(adap + (((size_t)l * 64) * 2 + b) * MODW) + n4;
#pragma unroll 8
        for (int ks = 0; ks < 64; ++ks) s = s + pp[(size_t)ks * 2 * (MODW / 4)];
        *((f32x4*)(mod + ((size_t)l * NBATCH + b) * MODW) + n4) = s;
    }
}
__device__ __forceinline__ void ph_final(PH_ARGS) { PHASE_IDS(); unsigned char* ws = WSP(); norm_rows_f32((const float*)(ws + WS_X), OUTP(), INP(23), gw, NGW, lane); }
#ifndef REPMASK
#define REPMASK 0
#endif
#define REP(j) (((REPMASK) >> (j)) & 1)
template <int layer>
__device__ __forceinline__ void layer_phases(const int lo, const int hi, PH_ARGS, const XcdBarrier& bar) {
    constexpr int pb = PH_LAYER0 + layer * PH_PER_LAYER;
    if (EN(0) && IN(pb + 0)) { if (REP(0)) ph_norm<layer, 0>(PH_PASS); ph_norm<layer, 0>(PH_PASS); }
    SEAM(pb + 0);
    if (EN(1) && IN(pb + 1)) { if (REP(1)) ph_gemm_in<layer>(PH_PASS); ph_gemm_in<layer>(PH_PASS); }
    SEAM(pb + 1);
    if (EN(2) && IN(pb + 2)) { if (REP(2)) { ph_local<layer>(PH_PASS); __syncthreads(); } ph_local<layer>(PH_PASS); }
    SEAM(pb + 2);
    if (EN(3) && IN(pb + 3)) { if (REP(3)) ph_carry<layer>(PH_PASS); ph_carry<layer>(PH_PASS); }
    SEAM(pb + 3);
    if (EN(4) && IN(pb + 4)) { if (REP(4)) { ph_outputs<layer>(PH_PASS); __syncthreads(); } if (REP(13)) { ph_outputs<layer, 1>(PH_PASS); __syncthreads(); } if (REP(14)) { ph_outputs<layer, 2>(PH_PASS); __syncthreads(); } ph_outputs<layer>(PH_PASS); }
    SEAM(pb + 4);
    if (EN(5) && IN(pb + 5)) { if (REP(5)) ph_glu<layer>(PH_PASS); ph_glu<layer>(PH_PASS); }
    SEAM(pb + 5);
    if (EN(6) && IN(pb + 6)) { if (REP(6)) { ph_out<layer, true>(PH_PASS); __syncthreads(); } ph_out<layer, false>(PH_PASS); }
    SEAM(pb + 6);
    if (EN(7) && IN(pb + 7)) { if (REP(7)) ph_norm<layer, 1>(PH_PASS); ph_norm<layer, 1>(PH_PASS); }
    SEAM(pb + 7);
    if (EN(8) && IN(pb + 8)) { if (REP(8)) ph_up<layer>(PH_PASS); ph_up<layer>(PH_PASS); }
    SEAM(pb + 8);
    if (EN(9) && IN(pb + 9)) { if (REP(9)) ph_down<layer, true>(PH_PASS); ph_down<layer, false>(PH_PASS); }
    SEAM(pb + 9);
}

__global__ void __launch_bounds__(NWAVES * 64, 2) trunk_fwd(Args args) {
    extern __shared__ __attribute__((aligned(16))) unsigned char lds_raw[];
    LAS unsigned char* lds = (LAS unsigned char*)lds_raw;
    volatile LAS unsigned* MISC = (volatile LAS unsigned*)(lds + MISC_OFF);
    const int G = gridDim.x; const int bx = blockIdx.x; const int vcu = (G % 8 == 0) ? (bx % 8) * (G / 8) + bx / 8 : bx;
    const int NGW = G * NWAVES;
    for (int u = threadIdx.x; u < (LDS_BYTES - LDSCTL_OFF) / 4; u += NWAVES * 64) ((LAS unsigned*)(lds + LDSCTL_OFF))[u] = 0u;
    __syncthreads();
#if MK_PER_PHASE
    XcdBarrier bar; bar.bar = nullptr; bar.x = 0; bar.st = nullptr;
#else
    XcdBarrier bar = xcd_barrier_post((unsigned*)(args.ws + WS_CTL) + CW_BAR, MISC + 8);
#endif
    const int lo = args.ph_lo, hi = args.ph_hi;

    if (EN(10) && IN(0)) { if (REP(10)) { ph_prologue(PH_PASS); __syncthreads(); } ph_prologue(PH_PASS); }
    SEAM(0);
    if (EN(11) && IN(1)) ph_mod(PH_PASS);
    SEAM(1);
    layer_phases<0>(lo, hi, G, bx, vcu, NGW, lds, bar);
    if (NLAYER_LOOP > 1) layer_phases<1>(lo, hi, G, bx, vcu, NGW, lds, bar);
    if (EN(12) && IN(PH_FINAL)) { if (REP(12)) ph_final(PH_PASS); ph_final(PH_PASS); }
#undef IN
#undef SEAM
}


extern "C" void kernel_launch(void* const* d_in, const int* in_sizes, int n_in, void* d_out, int out_size, void* d_ws, size_t ws_size, hipStream_t stream) {
    static int grid = 0;
    if (grid == 0) {
        if (n_in != 24 || in_sizes[0] != MR * DM || out_size != MR * DM || ws_size < WS_END + SZ_X) { fprintf(stderr, "kernel_launch: unexpected problem (n_in %d, in0 %d, out %d, ws %zu < %zu); nothing launched\n", n_in, n_in > 0 ? in_sizes[0] : -1, out_size, ws_size, (size_t)WS_END); grid = -1; return; }
        int dev = 0, cus = 0, per_cu = 0;
        if (hipGetDevice(&dev) != hipSuccess || hipDeviceGetAttribute(&cus, hipDeviceAttributeMultiprocessorCount, dev) != hipSuccess) { grid = -1; return; }
        if (hipFuncSetAttribute((const void*)trunk_fwd, hipFuncAttributeMaxDynamicSharedMemorySize, LDS_BYTES) != hipSuccess) { fprintf(stderr, "kernel_launch: hipFuncSetAttribute failed\n"); grid = -1; return; }
        if (hipOccupancyMaxActiveBlocksPerMultiprocessor(&per_cu, (const void*)trunk_fwd, NWAVES * 64, LDS_BYTES) != hipSuccess || per_cu < 1) fprintf(stderr, "kernel_launch: occupancy query reports %d workgroups per CU\n", per_cu);
        (void)hipGetLastError();
        grid = cus;
    }
    if (grid < 0) return;
    if (hipMemsetAsync((char*)d_ws + WS_CTL, 0, CTL_ZERO_BYTES, stream) != hipSuccess) return;
    Args a{};
    for (int i = 0; i < 24; ++i) a.in[i] = (const float*)d_in[i];
    a.out = (float*)d_out; a.ws = (unsigned char*)d_ws;
#if MK_PER_PHASE
    for (int p = 0; p < PH_COUNT; ++p) { a.ph_lo = p; a.ph_hi = p + 1; hipLaunchKernelGGL(trunk_fwd, dim3(grid), dim3(NWAVES * 64), LDS_BYTES, stream, a); }
#else
    a.ph_lo = 0; a.ph_hi = PH_COUNT;
    hipLaunchKernelGGL(trunk_fwd, dim3(grid), dim3(NWAVES * 64), LDS_BYTES, stream, a);
#endif
}
```
